# Optimizing an MI355X kernel written in HIP

```python
import jax, jax.numpy as jnp
from jax import lax
import numpy as np


D_MODEL = 1024
BATCH = 2
SEQ = 16384
DEPTH = 2

HEAD_DIM = 64
N_GROUPS = 4
GROUP_WIDTH = D_MODEL // N_GROUPS
D_MIX = N_GROUPS * GROUP_WIDTH
A_Q_HEADS = GROUP_WIDTH // HEAD_DIM
A_KV_HEADS = 2
D_Q_HEADS = GROUP_WIDTH // HEAD_DIM
D_KV_HEADS = 2
B_HEADS = GROUP_WIDTH // HEAD_DIM
C_HEADS = GROUP_WIDTH // HEAD_DIM
CONV_WIDTH = 3
WINDOW = 128
BLOCK = 128
GRID_W = 64
AXIS_DIM = HEAD_DIM // 2
ROPE_THETA = 10000.0
D_FF = 4 * D_MODEL
LN_EPS = 1e-5
RMS_EPS = 1e-6
DN_ALPHA = (2 * DEPTH) ** 0.25
DN_BETA = (8 * DEPTH) ** -0.25
NEG_INF = -1e30
SPLIT_SIZES = (
    A_Q_HEADS * HEAD_DIM, A_KV_HEADS * HEAD_DIM, A_KV_HEADS * HEAD_DIM,
    GROUP_WIDTH, GROUP_WIDTH, GROUP_WIDTH,
    GROUP_WIDTH,
    D_Q_HEADS * HEAD_DIM, D_KV_HEADS * HEAD_DIM, D_KV_HEADS * HEAD_DIM,
)
D_IN_PROJ = 2048

kernel_name = 'hymba_style_hybrid_encoder'


def layer_norm(x, g, b):
    xf = x.astype(jnp.float32)
    mu = jnp.mean(xf, axis=-1, keepdims=True)
    var = jnp.mean(jnp.square(xf - mu), axis=-1, keepdims=True)
    return ((xf - mu) * lax.rsqrt(var + LN_EPS) * g + b).astype(x.dtype)


def rms_norm(x, g):
    xf = x.astype(jnp.float32)
    return (xf * lax.rsqrt(jnp.mean(jnp.square(xf), axis=-1, keepdims=True) + RMS_EPS) * g).astype(x.dtype)


def split_columns(h):
    parts, start = [], 0
    for size in SPLIT_SIZES:
        parts.append(h[..., start:start + size])
        start += size
    return parts


def split_heads(t, n_heads):
    return t.reshape(t.shape[0], t.shape[1], n_heads, HEAD_DIM)


def windowed_gqa_sink(q, k, v, sink):
    b_, s_, hq, hd = q.shape
    hkv = k.shape[2]
    g_ = hq // hkv
    nblk = s_ // BLOCK
    qb = q.reshape(b_, nblk, BLOCK, hkv, g_, hd)

    def windows(t):
        tp = jnp.pad(t, ((0, 0), (BLOCK, BLOCK), (0, 0), (0, 0))).reshape(b_, nblk + 2, BLOCK, hkv, hd)
        return jnp.concatenate([tp[:, :-2], tp[:, 1:-1], tp[:, 2:]], axis=2)

    kw, vw = windows(k), windows(v)
    scores = jnp.einsum('bnqkgd,bnskd->bnkgqs', qb, kw, preferred_element_type=jnp.float32) * (hd ** -0.5)
    q_pos = jnp.arange(s_).reshape(nblk, BLOCK)
    k_pos = (jnp.arange(nblk)[:, None] - 1) * BLOCK + jnp.arange(3 * BLOCK)[None, :]
    dist = jnp.abs(q_pos[:, :, None] - k_pos[:, None, :])
    valid = (dist <= WINDOW) & ((k_pos >= 0) & (k_pos < s_))[:, None, :]
    slopes = jnp.exp2(-8.0 * jnp.arange(1, hq + 1, dtype=jnp.float32) / hq).reshape(hkv, g_)
    bias = -slopes[None, :, :, None, None] * dist.astype(jnp.float32)[:, None, None, :, :]
    scores = jnp.where(valid[:, None, None], scores + bias, NEG_INF)
    sink_col = jnp.broadcast_to(sink.astype(jnp.float32).reshape(hkv, g_, 1, 1), scores.shape[:-1] + (1,))
    probs = jax.nn.softmax(jnp.concatenate([scores, sink_col], axis=-1), axis=-1)[..., :-1]
    out = jnp.einsum('bnkgqs,bnskd->bnqkgd', probs.astype(v.dtype), vw)
    return out.reshape(b_, s_, hq * hd)


def short_conv_mixer(u, gate_b, gate_c, conv_w):
    z = gate_c * u
    y = lax.conv_general_dilated(
        z, conv_w[:, None, :], window_strides=(1,),
        padding=((CONV_WIDTH // 2, CONV_WIDTH // 2),),
        dimension_numbers=('NWC', 'WIO', 'NWC'),
        feature_group_count=z.shape[-1])
    return gate_b * y


def fourier_mixer(u):
    b_, s_, c_ = u.shape
    ug = u.astype(jnp.float32).reshape(b_, s_, C_HEADS, c_ // C_HEADS)
    y = jnp.fft.fft2(ug, axes=(1, 3), norm='ortho').real
    return y.reshape(b_, s_, c_).astype(u.dtype)


def rotate_half_axis(seg, ang):
    m = ang.shape[-1]
    c = jnp.cos(ang)[None, :, None, :]
    s = jnp.sin(ang)[None, :, None, :]
    x1, x2 = seg[..., :m], seg[..., m:]
    return jnp.concatenate([x1 * c - x2 * s, x2 * c + x1 * s], axis=-1)


def axial_rope(t, ang_row, ang_col):
    tf = t.astype(jnp.float32)
    out = jnp.concatenate([rotate_half_axis(tf[..., :AXIS_DIM], ang_row),
                           rotate_half_axis(tf[..., AXIS_DIM:], ang_col)], axis=-1)
    return out.astype(t.dtype)


def dense_gqa_blocks(q, k, v):
    b_, s_, hq, hd = q.shape
    hkv = k.shape[2]
    g_ = hq // hkv
    nblk = s_ // BLOCK
    qb = q.reshape(b_, nblk, BLOCK, hkv, g_, hd).transpose(1, 0, 2, 3, 4, 5)

    def one_block(q_blk):
        sc = jnp.einsum('bqkgd,bskd->bkgqs', q_blk, k, preferred_element_type=jnp.float32) * (hd ** -0.5)
        p = jax.nn.softmax(sc, axis=-1)
        return jnp.einsum('bkgqs,bskd->bqkgd', p.astype(v.dtype), v)

    out = lax.map(one_block, qb)
    return out.transpose(1, 0, 2, 3, 4, 5).reshape(b_, s_, hq * hd)


def setup_inputs(seed: int = 0) -> dict:
    key = jax.random.key(seed)
    ks = jax.random.split(key, 16)
    f32 = jnp.float32
    nrm = lambda k, shape: jax.random.normal(k, shape, dtype=f32)
    return {
        'x': nrm(ks[0], (BATCH, SEQ, D_MODEL)),
        'ln_in_g': 1.0 + 0.02 * nrm(ks[1], (D_MODEL,)),
        'ln_in_b': 0.02 * nrm(ks[2], (D_MODEL,)),
        'w_in': nrm(ks[3], (DEPTH, D_MODEL, D_IN_PROJ)) * D_MODEL ** -0.5,
        'conv_w': nrm(ks[4], (DEPTH, CONV_WIDTH, GROUP_WIDTH)) * CONV_WIDTH ** -0.5,
        'sink': 0.5 * nrm(ks[5], (DEPTH, A_Q_HEADS)),
        'qn_g': 1.0 + 0.02 * nrm(ks[6], (DEPTH, HEAD_DIM)),
        'kn_g': 1.0 + 0.02 * nrm(ks[7], (DEPTH, HEAD_DIM)),
        'grp_g': 1.0 + 0.02 * nrm(ks[8], (DEPTH, D_MIX)),
        'w_out': nrm(ks[9], (DEPTH, D_MIX, D_MODEL)) * (D_MIX ** -0.5) * DN_BETA,
        'ln1_g': 1.0 + 0.02 * nrm(ks[10], (DEPTH, D_MODEL)),
        'ln1_b': 0.02 * nrm(ks[11], (DEPTH, D_MODEL)),
        'w1': nrm(ks[12], (DEPTH, D_MODEL, D_FF)) * (D_MODEL ** -0.5) * DN_BETA,
        'w2': nrm(ks[13], (DEPTH, D_FF, D_MODEL)) * (D_FF ** -0.5) * DN_BETA,
        'ln2_g': 1.0 + 0.02 * nrm(ks[14], (DEPTH, D_MODEL)),
        'ln2_b': 0.02 * nrm(ks[15], (DEPTH, D_MODEL)),
    }


def reference(x, ln_in_g, ln_in_b, w_in, conv_w, sink, qn_g, kn_g, grp_g, w_out,
              ln1_g, ln1_b, w1, w2, ln2_g, ln2_b):
    f32 = jnp.float32
    b_, s_, _ = x.shape
    rows = s_ // GRID_W
    row_idx = jnp.repeat(jnp.arange(rows), GRID_W)
    col_idx = jnp.tile(jnp.arange(GRID_W), rows)
    inv_freq = ROPE_THETA ** (-jnp.arange(0, AXIS_DIM, 2, dtype=f32) / AXIS_DIM)
    ang_row = row_idx.astype(f32)[:, None] * inv_freq[None, :]
    ang_col = col_idx.astype(f32)[:, None] * inv_freq[None, :]

    h = layer_norm(x, ln_in_g, ln_in_b)
    for l in range(DEPTH):
        proj = h @ w_in[l]
        a_q, a_k, a_v, b_u, b_b, b_c, c_u, d_q, d_k, d_v = split_columns(proj)
        out_a = windowed_gqa_sink(split_heads(a_q, A_Q_HEADS), split_heads(a_k, A_KV_HEADS),
                                  split_heads(a_v, A_KV_HEADS), sink[l])
        out_b = short_conv_mixer(b_u, b_b, b_c, conv_w[l])
        out_c = fourier_mixer(c_u)
        qd = axial_rope(rms_norm(split_heads(d_q, D_Q_HEADS), qn_g[l]), ang_row, ang_col)
        kd = axial_rope(rms_norm(split_heads(d_k, D_KV_HEADS), kn_g[l]), ang_row, ang_col)
        out_d = dense_gqa_blocks(qd, kd, split_heads(d_v, D_KV_HEADS))
        g = grp_g[l]
        mix = jnp.concatenate(
            [rms_norm(o, g[i * GROUP_WIDTH:(i + 1) * GROUP_WIDTH])
             for i, o in enumerate((out_a, out_b, out_c, out_d))], axis=-1)
        h = layer_norm(DN_ALPHA * h + mix @ w_out[l], ln1_g[l], ln1_b[l])
        ffn = jnp.square(jax.nn.relu(h @ w1[l])) @ w2[l]
        h = layer_norm(DN_ALPHA * h + ffn, ln2_g[l], ln2_b[l])
    return h
```

```cpp
#include <hip/hip_runtime.h>
#include <hip/hip_cooperative_groups.h>
#include <cstdio>
#include <cstdint>
#include <hip/hip_bf16.h>
#include <cmath>
namespace cg = cooperative_groups;
__device__ __forceinline__ int mk_lane() { int t; asm volatile("v_mbcnt_lo_u32_b32 %0, -1, 0\n\tv_mbcnt_hi_u32_b32 %0, -1, %0" : "=&v"(t)); return t; }
__device__ __forceinline__ float mk_shfl_xor_l(float v, int m, int lane) { return __builtin_bit_cast(float, __builtin_amdgcn_ds_bpermute((lane ^ m) << 2, __builtin_bit_cast(int, v))); }
#define __shfl_xor(v, m) mk_shfl_xor_l((v), (m), mk_lane())
typedef long long fx_t;
constexpr double FX_ST = 1073741824.0, FX_SQ = 68719476736.0, FX_CS = 1099511627776.0;
__device__ __forceinline__ fx_t fx_from(float v, double sc) { return (fx_t)__builtin_rint((double)v * sc); }
__device__ __forceinline__ float fx_to(fx_t v, double sc) { const int hi = (int)(v >> 32); const unsigned lo = (unsigned)v;
    return (float)hi * (float)(4294967296.0 / sc) + (float)lo * (float)(1.0 / sc); }
__device__ __forceinline__ void fx_atomic_add(fx_t* p, fx_t v) { (void)__hip_atomic_fetch_add((unsigned long long*)p, (unsigned long long)v, __ATOMIC_RELAXED, __HIP_MEMORY_SCOPE_AGENT); }
__device__ __forceinline__ fx_t st_pack(float s, float q) { return (fx_t)(((unsigned long long)(unsigned)(int)__builtin_rintf(s * 131072.0f) << 32) + (unsigned long long)(unsigned)__builtin_rintf(q * 16384.0f)); }
__device__ __forceinline__ void st_unpack(fx_t v, float& s, float& q) { s = (float)(int)(v >> 32) * (1.0f / 131072.0f); q = (float)(unsigned)v * (1.0f / 16384.0f); }
namespace pg8 {
#define PG8_LAS __attribute__((address_space(3)))
typedef unsigned short bf16_t;
typedef short bf16x8 __attribute__((ext_vector_type(8)));
typedef float f32x4 __attribute__((ext_vector_type(4)));
typedef unsigned u32x4 __attribute__((ext_vector_type(4)));
constexpr int BM = 256, BK = 64, HALF = 128, HTB = HALF * BK * 2  , STAGE_BYTES = 8 * HTB, NXCD = 8, WGM = 8;

__host__ __device__ __forceinline__ int lds_byte(int r, int c) { const int st = (r >> 4) * 2 + (c >> 5), rr = r & 15, cc = c & 31, ob = rr * 64 + cc * 2; return st * 1024 + (ob ^ (((ob >> 9) & 1) << 5)); }
__host__ __device__ __forceinline__ void stage_rc(int b, int& R, int& C) { const int st = b / 1024, sb = b % 1024, swz = sb ^ (((sb >> 9) & 1) << 5); R = (st >> 1) * 16 + swz / 64; C = (st & 1) * 32 + (swz % 64) / 2; }
__host__ __device__ __forceinline__ int perm32(int rho) { const int n = rho >> 4, i = rho & 15; return 8 * (i >> 2) + 4 * n + (i & 3); }

struct Unit { int pm, pn; };
struct Gemm { const bf16_t* A; const bf16_t* Bt; int M, N, K; };

struct StaticOrder {
    int nM, nN, nwg, G, c;
    __host__ __device__ void init(int M, int N, int G_, int c_) { nM = M / BM; nN = N / BM; nwg = nM * nN; G = G_; c = c_; }
    __host__ __device__ bool next(int i, Unit& u) const {
        const long L = (long)i * G + c; if (L >= nwg) return false;
        int wgid = (int)L; { const int q = nwg / NXCD, r = nwg % NXCD, xcd = wgid % NXCD, off = wgid / NXCD; wgid = (xcd < r ? xcd * (q + 1) : r * (q + 1) + (xcd - r) * q) + off; }
        const int nig = WGM * nN, gid = wgid / nig, fm = gid * WGM, gsz = (nM - fm) < WGM ? (nM - fm) : WGM;
        u.pm = fm + ((wgid % nig) % gsz); u.pn = (wgid % nig) / gsz; return true;
    }
    __device__ __forceinline__ void a_ready(const Unit&) const {}
    __device__ __forceinline__ void done(const Unit&) const {}
};

__device__ __forceinline__ unsigned cvt_pk_bf16(float lo, float hi) { unsigned r; asm volatile("v_cvt_pk_bf16_f32 %0, %1, %2" : "=v"(r) : "v"(lo), "v"(hi)); return r; }
typedef float f32x2 __attribute__((ext_vector_type(2)));
__device__ __forceinline__ f32x2 gelu_pk(f32x2 v) {
    const f32x2 av = __builtin_elementwise_abs(v), d = av * 0.2316418882f + 1.0f;
    f32x2 t; t.x = __builtin_amdgcn_rcpf(d.x); t.y = __builtin_amdgcn_rcpf(d.y);
    f32x2 q = t * 0.5307027145f + (-0.7265760135f); q = q * t + 0.7107068705f; q = q * t + (-0.142248368f); q = q * t + 0.127414796f; q = q * t;
    const f32x2 s = (v * v) * (-0.72134752044f);
    f32x2 e; e.x = __builtin_amdgcn_exp2f(s.x); e.y = __builtin_amdgcn_exp2f(s.y);
    const f32x2 m = v * (q * e), r = v - m;
    f32x2 o; o.x = v.x < 0.f ? m.x : r.x; o.y = v.y < 0.f ? m.y : r.y; return o;
}

template <int ACT  > struct EpiBf16 {
    static constexpr bool PREFETCH = false;
    static constexpr bool PERM = true, AFTER_DRAIN = false; static_assert(ACT == 0 || ACT == 1 || ACT == 2, "EpiBf16: ACT is 0 (none), 1 (gelu_pk) or 2 (relu^2)");
    bf16_t* O; int ldc; const float* bias; int split_cols; size_t split_stride; float scale0;
    __device__ __forceinline__ void operator()(const f32x4 (&acc)[2][2][4][2], const Unit& u, int wr, int wc, int fr, int fq) const {
        const int row0 = u.pm * BM + wr * 64 + fr; int colt = u.pn * BM; bf16_t* base = O;
        float sc = 1.f; if (split_cols) { const int t = colt / split_cols; base += (size_t)t * split_stride; colt -= t * split_cols; if (t == 0) sc = scale0; }
        const int col0 = colt + wc * 32 + 8 * fq, bcol0 = u.pn * BM + wc * 32 + 8 * fq;
        f32x4 bv[2][2];
#pragma unroll
        for (int bj = 0; bj < 2; ++bj)
#pragma unroll
            for (int n = 0; n < 2; ++n) bv[bj][n] = bias ? *(const f32x4*)(bias + bcol0 + bj * HALF + 4 * n) : (f32x4){0.f, 0.f, 0.f, 0.f};
#pragma unroll
        for (int ai = 0; ai < 2; ++ai)
#pragma unroll
            for (int m = 0; m < 4; ++m) { bf16_t* rowp = base + (size_t)(row0 + ai * HALF + m * 16) * ldc + col0;
#pragma unroll
                for (int bj = 0; bj < 2; ++bj) { f32x4 v0 = acc[ai][bj][m][0] + bv[bj][0], v1 = acc[ai][bj][m][1] + bv[bj][1];
                    if (ACT == 1) { f32x2 a = gelu_pk((f32x2){v0[0], v0[1]}), b = gelu_pk((f32x2){v0[2], v0[3]}), c = gelu_pk((f32x2){v1[0], v1[1]}), d = gelu_pk((f32x2){v1[2], v1[3]});
                        v0 = (f32x4){a.x, a.y, b.x, b.y}; v1 = (f32x4){c.x, c.y, d.x, d.y}; }
                    if (ACT == 2) { v0 = __builtin_elementwise_max(v0, (f32x4){0.f, 0.f, 0.f, 0.f}); v1 = __builtin_elementwise_max(v1, (f32x4){0.f, 0.f, 0.f, 0.f}); v0 = v0 * v0; v1 = v1 * v1; }
                    v0 = v0 * sc; v1 = v1 * sc; u32x4 w; w.x = cvt_pk_bf16(v0[0], v0[1]); w.y = cvt_pk_bf16(v0[2], v0[3]); w.z = cvt_pk_bf16(v1[0], v1[1]); w.w = cvt_pk_bf16(v1[2], v1[3]);
                    *(u32x4*)(rowp + bj * HALF) = w; } }
    }
};

struct EpiResF32 {
    static constexpr bool PERM = false, AFTER_DRAIN = false, PREFETCH = false;
    float* H; int ldc; float alpha;
    __device__ __forceinline__ void operator()(const f32x4 (&acc)[2][2][4][2], const Unit& u, int wr, int wc, int fr, int fq) const {
        const int col0 = u.pn * BM + wc * 32 + 4 * fq;
#pragma unroll
        for (int ai = 0; ai < 2; ++ai)
#pragma unroll
            for (int m = 0; m < 4; ++m) { const int r = ai * HALF + wr * 64 + m * 16 + fr; float* rowp = H + (size_t)(u.pm * BM + r) * ldc + col0;
#pragma unroll
                for (int bj = 0; bj < 2; ++bj)
#pragma unroll
                    for (int n = 0; n < 2; ++n) { f32x4* p = (f32x4*)(rowp + bj * HALF + n * 16); const f32x4 b = *p; *p = b * alpha + acc[ai][bj][m][n]; }
                asm volatile("" ::: "memory"); }
    }
};

template <int ACT  , bool FXCS = false  > struct EpiLnBf16 {
    static constexpr bool PERM = true, AFTER_DRAIN = false;
    bf16_t* O; int ldc; const fx_t* st; const void* cs; const void* bw; float eps; PG8_LAS unsigned char* tab;
    static constexpr bool PREFETCH = !FXCS;
    __device__ __forceinline__ void prefetch(const Unit& u, int par, int wid, int lane) const {
        PG8_LAS unsigned char* t = tab + par * 4096;
        if (wid < 2) __builtin_amdgcn_global_load_lds((const unsigned*)(st + (size_t)u.pm * BM + wid * 128) + lane * 4, (PG8_LAS unsigned*)(t + wid * 1024), 16, 0, 0);
        else if (wid == 2) __builtin_amdgcn_global_load_lds((const unsigned*)((const float*)cs + u.pn * BM) + lane * 4, (PG8_LAS unsigned*)(t + 2048), 16, 0, 0);
        else if (wid == 3) __builtin_amdgcn_global_load_lds((const unsigned*)((const float*)bw + u.pn * BM) + lane * 4, (PG8_LAS unsigned*)(t + 3072), 16, 0, 0);
    }
    __device__ __forceinline__ void operator()(const f32x4 (&acc)[2][2][4][2], const Unit& u, int wr, int wc, int fr, int fq, int par = 0) const {
        const int row0 = u.pm * BM + wr * 64 + fr, col0 = u.pn * BM + wc * 32 + 8 * fq;
        f32x4 cv[2][2], bv[2][2];
#pragma unroll
        for (int bj = 0; bj < 2; ++bj)
#pragma unroll
            for (int n = 0; n < 2; ++n) { const int cc = col0 + bj * HALF + 4 * n;
                if constexpr (FXCS) { const fx_t* cp = (const fx_t*)cs + cc; const fx_t* bp = (const fx_t*)bw + cc;
                    cv[bj][n] = (f32x4){fx_to(cp[0], FX_CS), fx_to(cp[1], FX_CS), fx_to(cp[2], FX_CS), fx_to(cp[3], FX_CS)}; bv[bj][n] = (f32x4){fx_to(bp[0], FX_CS), fx_to(bp[1], FX_CS), fx_to(bp[2], FX_CS), fx_to(bp[3], FX_CS)}; }
                else { const int lc = wc * 32 + 8 * fq + bj * HALF + 4 * n; cv[bj][n] = *(const PG8_LAS f32x4*)(tab + par * 4096 + 2048 + lc * 4); bv[bj][n] = *(const PG8_LAS f32x4*)(tab + par * 4096 + 3072 + lc * 4); } }
        fx_t swv[2][4];
#pragma unroll
        for (int ai = 0; ai < 2; ++ai)
#pragma unroll
            for (int m = 0; m < 4; ++m) swv[ai][m] = FXCS ? st[row0 + ai * HALF + m * 16] : *(const PG8_LAS fx_t*)(tab + par * 4096 + (ai * HALF + wr * 64 + m * 16 + fr) * 8);
#pragma unroll
        for (int ai = 0; ai < 2; ++ai)
#pragma unroll
            for (int m = 0; m < 4; ++m) { const int row = row0 + ai * HALF + m * 16; f32x2 sv; { float s_, q_; st_unpack(swv[ai][m], s_, q_); sv = (f32x2){s_, q_}; }
                const float mean = sv.x * (1.0f / 1024.0f), rstd = __builtin_amdgcn_rsqf(sv.y * (1.0f / 1024.0f) - mean * mean + eps), mr = -mean * rstd;
                bf16_t* rowp = O + (size_t)row * ldc + col0;
#pragma unroll
                for (int bj = 0; bj < 2; ++bj) { f32x4 v0 = acc[ai][bj][m][0] * rstd + (cv[bj][0] * mr + bv[bj][0]), v1 = acc[ai][bj][m][1] * rstd + (cv[bj][1] * mr + bv[bj][1]);
                    if (ACT == 2) { v0 = __builtin_elementwise_max(v0, (f32x4){0.f, 0.f, 0.f, 0.f}); v1 = __builtin_elementwise_max(v1, (f32x4){0.f, 0.f, 0.f, 0.f}); v0 = v0 * v0; v1 = v1 * v1; }
                    u32x4 w; w.x = cvt_pk_bf16(v0[0], v0[1]); w.y = cvt_pk_bf16(v0[2], v0[3]); w.z = cvt_pk_bf16(v1[0], v1[1]); w.w = cvt_pk_bf16(v1[2], v1[3]);
                    *(u32x4*)(rowp + bj * HALF) = w; } }
    }
};
struct EpiResLn {
    static constexpr bool PERM = false, AFTER_DRAIN = false, PREFETCH = false;
    bf16_t* Y; int ldc; const fx_t* st_in; fx_t* st_out; const float* g; const float* b; float alpha, eps;
    __device__ __forceinline__ void operator()(const f32x4 (&acc)[2][2][4][2], const Unit& u, int wr, int wc, int fr, int fq) const {
        typedef unsigned u32x2 __attribute__((ext_vector_type(2)));
        const int col0 = u.pn * BM + wc * 32 + 4 * fq;
        f32x4 gv[2][2], bv[2][2];
#pragma unroll
        for (int bj = 0; bj < 2; ++bj)
#pragma unroll
            for (int n = 0; n < 2; ++n) { gv[bj][n] = *(const f32x4*)(g + col0 + bj * HALF + n * 16); bv[bj][n] = *(const f32x4*)(b + col0 + bj * HALF + n * 16); }
#pragma unroll
        for (int ai = 0; ai < 2; ++ai) {
            u32x2 yv[4][2][2]; fx_t sw[4];
#pragma unroll
            for (int m = 0; m < 4; ++m) { const int row = u.pm * BM + ai * HALF + wr * 64 + m * 16 + fr; sw[m] = st_in[row];
                const bf16_t* rowp = Y + (size_t)row * ldc + col0;
#pragma unroll
                for (int bj = 0; bj < 2; ++bj)
#pragma unroll
                    for (int n = 0; n < 2; ++n) yv[m][bj][n] = *(const u32x2*)(rowp + bj * HALF + n * 16); }
#pragma unroll
            for (int m = 0; m < 4; ++m) { const int row = u.pm * BM + ai * HALF + wr * 64 + m * 16 + fr; float s_, q_; st_unpack(sw[m], s_, q_);
                const float mean = s_ * (1.0f / 1024.0f), rstd = __builtin_amdgcn_rsqf(q_ * (1.0f / 1024.0f) - mean * mean + eps);
                bf16_t* rowp = Y + (size_t)row * ldc + col0; float s = 0.f, q = 0.f;
#pragma unroll
                for (int bj = 0; bj < 2; ++bj)
#pragma unroll
                    for (int n = 0; n < 2; ++n) { u32x2* p = (u32x2*)(rowp + bj * HALF + n * 16); const u32x2 yw = yv[m][bj][n];
                        f32x4 y = (f32x4){__builtin_bit_cast(float, yw.x << 16), __builtin_bit_cast(float, yw.x & 0xffff0000u), __builtin_bit_cast(float, yw.y << 16), __builtin_bit_cast(float, yw.y & 0xffff0000u)};
                        const f32x4 h = (y - mean) * rstd * gv[bj][n] + bv[bj][n]; const f32x4 yn = h * alpha + acc[ai][bj][m][n];
                        u32x2 w; w.x = cvt_pk_bf16(yn[0], yn[1]); w.y = cvt_pk_bf16(yn[2], yn[3]); *p = w;
                        const float r0 = __builtin_bit_cast(float, w.x << 16), r1 = __builtin_bit_cast(float, w.x & 0xffff0000u), r2 = __builtin_bit_cast(float, w.y << 16), r3 = __builtin_bit_cast(float, w.y & 0xffff0000u);
                        s += (r0 + r1) + (r2 + r3); q += (r0 * r0 + r1 * r1) + (r2 * r2 + r3 * r3); }
                s += __shfl_xor(s, 16); s += __shfl_xor(s, 32); q += __shfl_xor(q, 16); q += __shfl_xor(q, 32);
                if (fq == 0) fx_atomic_add(st_out + row, st_pack(s, q)); }
            asm volatile("" ::: "memory");
        }
    }
};

struct NoScale { static constexpr bool ON = false; };
struct GroupScale { static constexpr bool ON = true; const fx_t* ssq;   float eps; PG8_LAS float* rtab;
    __device__ __forceinline__ void prepare(const Unit& u, int par, int tid) const {
        if (__builtin_amdgcn_readfirstlane(tid >> 6) < 4) {   const fx_t* qp = ssq + 4 * (size_t)(u.pm * BM + tid); const f32x4 q = (f32x4){fx_to(qp[0], FX_SQ), fx_to(qp[1], FX_SQ), fx_to(qp[2], FX_SQ), fx_to(qp[3], FX_SQ)};
            const float a0 = q[0] * (1.0f / 256.0f) + eps, a1 = q[1] * (1.0f / 256.0f) + eps, a2 = q[2] * (1.0f / 256.0f) + eps, a3 = q[3] * (1.0f / 256.0f) + eps;
            *(PG8_LAS f32x4*)(rtab + par * 1024 + tid * 4) = (f32x4){sqrtf(a1 / a0), sqrtf(a2 / a1), sqrtf(a3 / a2), 1.0f / sqrtf(a3)}; }
    }
    __device__ __forceinline__ void scale(int j, int par, f32x4 (&acc)[2][2][4][2], int wr, int fr) const {
#pragma unroll
        for (int ai = 0; ai < 2; ++ai)
#pragma unroll
            for (int m = 0; m < 4; ++m) { const float f = rtab[par * 1024 + (ai * HALF + wr * 64 + m * 16 + fr) * 4 + j];
#pragma unroll
                for (int bj = 0; bj < 2; ++bj)
#pragma unroll
                    for (int n = 0; n < 2; ++n) acc[ai][bj][m][n] *= f; }
    }
};
template <class Epi, class Sched, bool ALIGN_EPI = false, bool SP2 = false, class RS = NoScale>
__device__ __forceinline__ void gemm_phase(PG8_LAS unsigned char* lds, const Gemm g, const Sched& S, const Epi& E, int tid_in, const RS& R = RS()) {
    int tid_ = tid_in; asm volatile("" : "+v"(tid_));
    const int tid = tid_, wid = __builtin_amdgcn_readfirstlane(tid >> 6), lane = tid & 63, wr = wid >> 2, wc = wid & 3, fr = lane & 15, fq = lane >> 4;
    const int K = g.K, nt = K / BK;
    unsigned voffA[2], voffB[2];
#pragma unroll
    for (int i = 0; i < 2; ++i) { int R, C; stage_rc(tid * 16 + i * 8192, R, C); const int Rb = Epi::PERM ? ((R & ~31) + perm32(R & 31)) : R;
        voffA[i] = (unsigned)(R * K + C) * 2u; voffB[i] = (unsigned)(Rb * K + C) * 2u; }
    const size_t kstep = (size_t)(BK * 2);
    const size_t hstep = (size_t)HALF * K * 2;
    const size_t tstep = 2 * hstep;
    const unsigned ldsw = (unsigned)wid * 1024u;
    const int aoff = lds_byte(wr * 64 + fr, fq * 8), boff = lds_byte(wc * 32 + fr, fq * 8);
#define PG8_SA(b, h) (((b) * 2 + (h)) * HTB)
#define PG8_SB(b, h) ((4 + (b) * 2 + (h)) * HTB)
#define PG8_STAGE(bufoff, gbase, voff) do { _Pragma("unroll") for (int _i = 0; _i < 2; ++_i) \
        __builtin_amdgcn_global_load_lds((const unsigned*)((const char*)(gbase) + (voff)[_i]), (PG8_LAS unsigned*)(lds + (bufoff) + ldsw + _i * 8192), 16, 0, 0); } while (0)
#define PG8_LDA(dst, b, h) do { _Pragma("unroll") for (int m = 0; m < 4; ++m) _Pragma("unroll") for (int k = 0; k < 2; ++k) dst[m][k] = *(const PG8_LAS bf16x8*)(lds + PG8_SA(b, h) + aoff + m * 2048 + k * 1024); } while (0)
#define PG8_LDB(dst, b, h) do { _Pragma("unroll") for (int n = 0; n < 2; ++n) _Pragma("unroll") for (int k = 0; k < 2; ++k) dst[n][k] = *(const PG8_LAS bf16x8*)(lds + PG8_SB(b, h) + boff + n * 2048 + k * 1024); } while (0)
#define PG8_MMA(ai, bj, At, Bt) do { __builtin_amdgcn_s_setprio(1); _Pragma("unroll") for (int m = 0; m < 4; ++m) _Pragma("unroll") for (int n = 0; n < 2; ++n) _Pragma("unroll") for (int k = 0; k < 2; ++k) \
        acc[ai][bj][m][n] = __builtin_amdgcn_mfma_f32_16x16x32_bf16(Bt[n][k], At[m][k], acc[ai][bj][m][n], 0, 0, 0); __builtin_amdgcn_s_setprio(0); } while (0)
#define PG8_WAIT_V(n) asm volatile("s_waitcnt vmcnt(" #n ")" ::: "memory")
#define PG8_WAIT_L(n) asm volatile("s_waitcnt lgkmcnt(" #n ")" ::: "memory")
#define PG8_BAR __builtin_amdgcn_s_barrier()
#define PG8_SCHED __builtin_amdgcn_sched_barrier(0)
    Unit cur, nxt; int ui = 0;
    if (!S.next(0, cur)) return;
    f32x4 acc[2][2][4][2];
#pragma unroll
    for (int a = 0; a < 2; ++a)
#pragma unroll
        for (int b = 0; b < 2; ++b)
#pragma unroll
            for (int m = 0; m < 4; ++m)
#pragma unroll
                for (int n = 0; n < 2; ++n) acc[a][b][m][n] = (f32x4){0.f, 0.f, 0.f, 0.f};
    bf16x8 At[4][2], B0[2][2], B1[2][2];
    const char* cA = (const char*)g.A + (size_t)cur.pm * tstep; const char* cB = (const char*)g.Bt + (size_t)cur.pn * tstep;
    S.a_ready(cur);
    if constexpr (SP2) {
        PG8_STAGE(PG8_SB(0, 0), cB, voffB); PG8_STAGE(PG8_SB(0, 1), cB + hstep, voffB); PG8_STAGE(PG8_SA(0, 0), cA, voffA); PG8_STAGE(PG8_SA(0, 1), cA + hstep, voffA);
        if (wr == 1) PG8_BAR;
        PG8_WAIT_V(2); PG8_BAR;
        PG8_STAGE(PG8_SB(1, 0), cB + kstep, voffB); PG8_STAGE(PG8_SA(1, 0), cA + kstep, voffA); PG8_STAGE(PG8_SB(1, 1), cB + hstep + kstep, voffB);
        PG8_WAIT_V(6); PG8_BAR;
    } else {
        PG8_STAGE(PG8_SB(0, 0), cB, voffB); PG8_STAGE(PG8_SA(0, 0), cA, voffA); PG8_STAGE(PG8_SB(0, 1), cB + hstep, voffB); PG8_STAGE(PG8_SA(0, 1), cA + hstep, voffA);
        if (wr == 1) PG8_BAR;
        PG8_WAIT_V(4); PG8_BAR;
        PG8_STAGE(PG8_SB(1, 0), cB + kstep, voffB); PG8_STAGE(PG8_SA(1, 0), cA + kstep, voffA); PG8_STAGE(PG8_SB(1, 1), cB + hstep + kstep, voffB);
        PG8_WAIT_V(6); PG8_BAR;
    }
    for (;;) {
        const bool has_next = S.next(ui + 1, nxt);
        if constexpr (Epi::PREFETCH) E.prefetch(cur, ui & 1, wid, lane);
        const char* nA = has_next ? (const char*)g.A + (size_t)nxt.pm * tstep : cA; const char* nB = has_next ? (const char*)g.Bt + (size_t)nxt.pn * tstep : cB;
        const int tseg = RS::ON ? 4 : nt;
        for (int t0 = 0; t0 < nt; t0 += tseg) {
        if constexpr (RS::ON) { if (t0 != 0) R.scale((t0 >> 2) - 1, ui & 1, acc, wr, fr); }
        for (int t = t0; t < t0 + tseg; t += 2) {
            const bool last = (t == nt - 2);
            const char* a1 = cA + (size_t)(t + 1) * kstep;
            const char* a2 = last ? nA : cA + (size_t)(t + 2) * kstep; const char* b2 = last ? nB : cB + (size_t)(t + 2) * kstep;
            const char* a3 = a2 + kstep; const char* b3 = b2 + kstep;
            if (last && has_next) S.a_ready(nxt);
            if constexpr (SP2) {
            PG8_LDB(B0, 0, 0); PG8_LDB(B1, 0, 1); PG8_SCHED; PG8_LDA(At, 0, 0); PG8_STAGE(PG8_SA(1, 1), a1 + hstep, voffA);
            PG8_WAIT_V(8); PG8_WAIT_L(0); PG8_BAR; PG8_MMA(0, 0, At, B0); PG8_MMA(0, 1, At, B1); PG8_BAR; PG8_SCHED;
            PG8_LDA(At, 0, 1); PG8_STAGE(PG8_SB(0, 0), b2, voffB); PG8_STAGE(PG8_SB(0, 1), b2 + hstep, voffB); PG8_STAGE(PG8_SA(0, 0), a2, voffA);
            PG8_WAIT_V(8); PG8_WAIT_L(0); PG8_BAR; PG8_MMA(1, 0, At, B0); PG8_MMA(1, 1, At, B1); PG8_BAR; PG8_SCHED;
            PG8_LDB(B0, 1, 0); PG8_LDB(B1, 1, 1); PG8_SCHED; PG8_LDA(At, 1, 0); PG8_STAGE(PG8_SA(0, 1), a2 + hstep, voffA);
            PG8_WAIT_V(8); PG8_WAIT_L(0); PG8_BAR; PG8_MMA(0, 0, At, B0); PG8_MMA(0, 1, At, B1); PG8_BAR; PG8_SCHED;
            PG8_LDA(At, 1, 1); PG8_STAGE(PG8_SB(1, 0), b3, voffB); PG8_STAGE(PG8_SB(1, 1), b3 + hstep, voffB); PG8_STAGE(PG8_SA(1, 0), a3, voffA);
            PG8_WAIT_V(8); PG8_WAIT_L(0); PG8_BAR; PG8_MMA(1, 0, At, B0); PG8_MMA(1, 1, At, B1); PG8_BAR; PG8_SCHED;
            } else {
            PG8_LDB(B0, 0, 0); PG8_SCHED; PG8_LDA(At, 0, 0); PG8_STAGE(PG8_SA(1, 1), a1 + hstep, voffA);
            PG8_WAIT_L(8); PG8_BAR; PG8_WAIT_L(0); PG8_MMA(0, 0, At, B0); PG8_BAR; PG8_SCHED;
            PG8_LDB(B1, 0, 1); PG8_STAGE(PG8_SB(0, 0), b2, voffB);
            PG8_BAR; PG8_WAIT_L(0); PG8_MMA(0, 1, At, B1); PG8_BAR;
            PG8_LDA(At, 0, 1); PG8_STAGE(PG8_SA(0, 0), a2, voffA);
            PG8_BAR; PG8_WAIT_L(0); PG8_MMA(1, 0, At, B0); PG8_BAR; PG8_SCHED;
            PG8_STAGE(PG8_SB(0, 1), b2 + hstep, voffB);
            PG8_WAIT_V(6); PG8_BAR; PG8_MMA(1, 1, At, B1); PG8_BAR;
            PG8_LDB(B0, 1, 0); PG8_SCHED; PG8_LDA(At, 1, 0); PG8_STAGE(PG8_SA(0, 1), a2 + hstep, voffA);
            PG8_WAIT_L(8); PG8_BAR; PG8_WAIT_L(0); PG8_MMA(0, 0, At, B0); PG8_BAR; PG8_SCHED;
            PG8_LDB(B1, 1, 1); PG8_STAGE(PG8_SB(1, 0), b3, voffB);
            PG8_BAR; PG8_WAIT_L(0); PG8_MMA(0, 1, At, B1); PG8_BAR;
            PG8_LDA(At, 1, 1); PG8_STAGE(PG8_SA(1, 0), a3, voffA);
            PG8_BAR; PG8_WAIT_L(0); PG8_MMA(1, 0, At, B0); PG8_BAR; PG8_SCHED;
            PG8_STAGE(PG8_SB(1, 1), b3 + hstep, voffB);
            PG8_WAIT_V(6); PG8_BAR; PG8_MMA(1, 1, At, B1); PG8_BAR;
            }
        }
        }
        if constexpr (ALIGN_EPI) { if (wr == 0) PG8_BAR; }
        if constexpr (RS::ON) R.scale(3, ui & 1, acc, wr, fr);
        if constexpr (!Epi::AFTER_DRAIN) { if constexpr (Epi::PREFETCH) E(acc, cur, wr, wc, fr, fq, ui & 1); else E(acc, cur, wr, wc, fr, fq); S.done(cur); }
        if (!has_next) break;
#pragma unroll
        for (int a = 0; a < 2; ++a)
#pragma unroll
            for (int b = 0; b < 2; ++b)
#pragma unroll
                for (int m = 0; m < 4; ++m)
#pragma unroll
                    for (int n = 0; n < 2; ++n) acc[a][b][m][n] = (f32x4){0.f, 0.f, 0.f, 0.f};
        cur = nxt; cA = nA; cB = nB; ++ui;
        if constexpr (ALIGN_EPI) { if (wr == 1) PG8_BAR; }
    }
    PG8_WAIT_V(0);
    if constexpr (!ALIGN_EPI) { if (wr == 0) PG8_BAR; }
    PG8_BAR;
    if constexpr (Epi::AFTER_DRAIN) { E.fused(acc, cur, wr, wc, fr, fq, lds, wid, lane); S.done(cur); }
#undef PG8_SA
#undef PG8_SB
#undef PG8_STAGE
#undef PG8_LDA
#undef PG8_LDB
#undef PG8_MMA
#undef PG8_WAIT_V
#undef PG8_WAIT_L
#undef PG8_BAR
#undef PG8_SCHED
}
}
#include <hip/hip_bf16.h>
#include <cmath>
namespace attn_body {
using bf16=__hip_bfloat16;
using bf16x8=__attribute__((ext_vector_type(8)))short;
using s16x4=__attribute__((ext_vector_type(4)))short;
using f32x16=__attribute__((ext_vector_type(16)))float;
using u32x4=__attribute__((ext_vector_type(4)))unsigned;
constexpr int BATCH=2,NHEAD=4,SEQ=16384,D=64;
constexpr int QP=2048,KP=128,VP=2048,OP=1024;
constexpr int NW=8,QBLK=32,QB=QBLK*NW,KVBLK=64,NQB=SEQ/QB;
constexpr int ATTN_UNIT_ROWS=QB;
__device__ __forceinline__ int crow(int r,int hi){return (r&3)+8*(r>>2)+4*hi;}
#define SBAR() __builtin_amdgcn_sched_barrier(0)
__device__ __forceinline__ void cmask(f32x16&p0,f32x16&p1,int jb,int qrel,int hi){
  const float NEG=-INFINITY; int kb=64*jb+4*hi;
  #pragma unroll
  for(int r=0;r<16;++r){int kv=kb+(r&3)+8*(r>>2); if(kv>qrel)p0[r]=NEG; if(kv+32>qrel)p1[r]=NEG;}
}

constexpr int NSLOT=3, SLOTB=8192;
constexpr int LDS_K=0, LDS_V=NSLOT*SLOTB, LDS_WS=2*NSLOT*SLOTB, LDS_OST=LDS_WS+NW*64*4, LDS_BYTES=LDS_OST+NW*4096;
constexpr float C2=0.125f*1.4426950408889634f;
__device__ __forceinline__ void glds16(const void*gsrc,unsigned lds_dst){unsigned keep;
  asm volatile("s_mov_b32 %0, m0\n\ts_mov_b32 m0, %2\n\ts_nop 0\n\tglobal_load_lds_dwordx4 %1, off\n\ts_mov_b32 m0, %0":"=&s"(keep):"v"(gsrc),"s"(lds_dst):"memory");}
__device__ __forceinline__ float max3f(float a,float b,float c){float r;asm("v_max3_f32 %0, %1, %2, %3":"=v"(r):"v"(a),"v"(b),"v"(c));return r;}
__device__ __forceinline__ float max2f(float a,float b){float r;asm("v_max_f32_e32 %0, %1, %2":"=v"(r):"v"(a),"v"(b));return r;}
__device__ __forceinline__ float fadd_s(float a,float b){float r;asm("v_add_f32_e32 %0, %1, %2":"=v"(r):"v"(a),"v"(b));return r;}
__device__ __forceinline__ float fsub_s(float a,float b){float r;asm("v_sub_f32_e32 %0, %1, %2":"=v"(r):"v"(a),"v"(b));return r;}
typedef float f32x2_t __attribute__((ext_vector_type(2))); typedef __bf16 bf16x2_t __attribute__((ext_vector_type(2)));
__device__ __forceinline__ unsigned cvtpk_s(float lo,float hi){f32x2_t v={lo,hi};bf16x2_t b=__builtin_convertvector(v,bf16x2_t);return __builtin_bit_cast(unsigned,b);}
#define WAIT_BAR(N) asm volatile("s_waitcnt vmcnt(" #N ") lgkmcnt(0)\n\ts_barrier":::"memory")

__device__ __forceinline__ void qkt(f32x16&p0,f32x16&p1,const char*Kslot,const bf16x8*qr,const f32x16&negm,int r32,int hi){
  const char*kb=Kslot+hi*1024+r32*16;
  #pragma unroll
  for(int d0=0;d0<4;++d0){
    const bf16x8 b0=*reinterpret_cast<const bf16x8*>(kb+d0*2048);
    const bf16x8 b1=*reinterpret_cast<const bf16x8*>(kb+d0*2048+512);
    if(d0==0){p0=__builtin_amdgcn_mfma_f32_32x32x16_bf16(b0,qr[0],negm,0,0,0);p1=__builtin_amdgcn_mfma_f32_32x32x16_bf16(b1,qr[0],negm,0,0,0);}
    else{p0=__builtin_amdgcn_mfma_f32_32x32x16_bf16(b0,qr[d0],p0,0,0,0);p1=__builtin_amdgcn_mfma_f32_32x32x16_bf16(b1,qr[d0],p1,0,0,0);}}
}
typedef __attribute__((address_space(3))) const char* lds_cptr;
typedef short v4i16_t __attribute__((ext_vector_type(4)));
__device__ __forceinline__ void kload8(bf16x8*kf,lds_cptr kp){
  kf[0]=*(const __attribute__((address_space(3))) bf16x8*)(kp);      kf[1]=*(const __attribute__((address_space(3))) bf16x8*)(kp+512);
  kf[2]=*(const __attribute__((address_space(3))) bf16x8*)(kp+2048); kf[3]=*(const __attribute__((address_space(3))) bf16x8*)(kp+2560);
  kf[4]=*(const __attribute__((address_space(3))) bf16x8*)(kp+4096); kf[5]=*(const __attribute__((address_space(3))) bf16x8*)(kp+4608);
  kf[6]=*(const __attribute__((address_space(3))) bf16x8*)(kp+6144); kf[7]=*(const __attribute__((address_space(3))) bf16x8*)(kp+6656);
}
__device__ __forceinline__ void kload2(bf16x8*kf,lds_cptr kp,int j){ kf[2*j]=*(const __attribute__((address_space(3))) bf16x8*)(kp+j*2048); kf[2*j+1]=*(const __attribute__((address_space(3))) bf16x8*)(kp+j*2048+512); }
__device__ __forceinline__ s16x4 vtr(lds_cptr p){ return __builtin_bit_cast(s16x4,__builtin_amdgcn_ds_read_tr16_b64_v4i16((__attribute__((address_space(3))) v4i16_t*)p)); }
__device__ __forceinline__ float rowmax(const f32x16&p0,const f32x16&p1){
  float a=max3f(p0[0],p0[1],p1[0]),b=max3f(p0[2],p0[3],p1[1]);a=max3f(a,p1[2],p1[3]);
  #pragma unroll
  for(int r=4;r<16;r+=4){a=max3f(a,p0[r],p0[r+1]);b=max3f(b,p0[r+2],p0[r+3]);a=max3f(a,p1[r],p1[r+1]);b=max3f(b,p1[r+2],p1[r+3]);}
  const float m=max2f(a,b);
  auto rr=__builtin_amdgcn_permlane32_swap(__float_as_uint(m),__float_as_uint(m),false,false);
  return max2f(__uint_as_float(rr[0]),__uint_as_float(rr[1]));
}
__device__ __forceinline__ void pv(f32x16*o,int vb,bf16x8 pa0,bf16x8 pa1,bf16x8 pa2,bf16x8 pa3){
  #pragma unroll
  for(int d0=0;d0<2;++d0){s16x4 lo[4],hi[4];
    #pragma unroll
    for(int ks=0;ks<4;++ks){
      asm volatile("ds_read_b64_tr_b16 %0,%1 offset:%c2":"=&v"(lo[ks]):"v"(vb),"i"(d0*4096+ks*1024):"memory");
      asm volatile("ds_read_b64_tr_b16 %0,%1 offset:%c2":"=&v"(hi[ks]):"v"(vb),"i"(d0*4096+ks*1024+512):"memory");}
    asm volatile("s_waitcnt lgkmcnt(0)":::"memory");SBAR();
    #define PK(k) (bf16x8){lo[k][0],lo[k][1],lo[k][2],lo[k][3],hi[k][0],hi[k][1],hi[k][2],hi[k][3]}
    o[d0]=__builtin_amdgcn_mfma_f32_32x32x16_bf16(pa0,PK(0),o[d0],0,0,0);
    o[d0]=__builtin_amdgcn_mfma_f32_32x32x16_bf16(pa1,PK(1),o[d0],0,0,0);
    o[d0]=__builtin_amdgcn_mfma_f32_32x32x16_bf16(pa2,PK(2),o[d0],0,0,0);
    o[d0]=__builtin_amdgcn_mfma_f32_32x32x16_bf16(pa3,PK(3),o[d0],0,0,0);
    #undef PK
  }
}

#ifndef ATTN_STORE16
#define ATTN_STORE16(p,v) (*(u32x4*)(p)=(v))
#endif
template<int THRL> __device__ __forceinline__ void attn_unit(int b,int h,int qb,const bf16*Q,const bf16*__restrict__ K,const bf16*__restrict__ V,bf16*O,char*shm,const float*__restrict__ qg,const float*__restrict__ kg,fx_t*ssq,int tid_in){
  int tid_=tid_in; asm volatile("":"+v"(tid_)); const int tid=tid_,lane=tid&63,r32=lane&31,hi=lane>>5; const int wid=__builtin_amdgcn_readfirstlane(tid>>6);
  const long rowbase=(long)b*SEQ; const int q0=qb*QB;
  const bf16*Qw=Q+(rowbase+q0+wid*QBLK)*QP+h*D;
  const bf16*Kh=K+rowbase*KP+(h>>1)*D,*Vh=V+rowbase*VP+(h>>1)*D;
  const unsigned lds0=(unsigned)(uintptr_t)shm;
  float*wsf=(float*)(shm+LDS_WS)+wid*64;
  const bf16*ksrc=Kh+(long)lane*KP+wid*8;
  const bf16*vsrc=Vh+(long)(16*(wid&3)+(lane>>2))*VP+(wid>>2)*32+(lane&3)*8;
  const unsigned kdst=lds0+LDS_K+wid*1024, vdst=lds0+LDS_V+wid*1024;
  #define DMA_K(t,slot) glds16(ksrc+(long)(t)*KVBLK*KP,(unsigned)__builtin_amdgcn_readfirstlane(kdst+(slot)))
  #define DMA_V(t,slot) glds16(vsrc+(long)(t)*KVBLK*VP,(unsigned)__builtin_amdgcn_readfirstlane(vdst+(slot)))
  const int vb0=(int)(lds0+LDS_V)+((lane>>4)&1)*32+(lane&3)*8+(4*hi+((lane&15)>>2))*64;
  const char*Kbase=shm+LDS_K; bf16x8 kf[8];
  const lds_cptr shm3=(lds_cptr)shm; const lds_cptr kp0=shm3+LDS_K+hi*1024+r32*16; const lds_cptr vp0=shm3+LDS_V+((lane>>4)&1)*32+(lane&3)*8+(4*hi+((lane&15)>>2))*64;
  const int NT=SEQ/KVBLK;
  DMA_K(0,0);DMA_V(0,0);DMA_K(1,SLOTB);
  bf16x8 qr[4];
  { float xq[4][8]; float ss=0.f;
    #pragma unroll
    for(int d0=0;d0<4;++d0){ const bf16x8 raw=*reinterpret_cast<const bf16x8*>(&Qw[(long)r32*QP+d0*16+hi*8]);
      #pragma unroll
      for(int e=0;e<8;++e){ const float v=__builtin_bit_cast(float,((unsigned)(unsigned short)raw[e])<<16); xq[d0][e]=v; ss+=v*v; } }
    { auto rr=__builtin_amdgcn_permlane32_swap(__float_as_uint(ss),__float_as_uint(ss),false,false); ss=__uint_as_float(rr[0])+__uint_as_float(rr[1]); }
    const float rstd=C2/sqrtf(ss*(1.0f/64.0f)+1e-6f);
    const int tq=q0+wid*QBLK+r32; const float prow=(float)(tq>>6), pcol=(float)(tq&63);
    #pragma unroll
    for(int d0=0;d0<4;++d0)
      #pragma unroll
      for(int e=0;e<8;++e) xq[d0][e]*=rstd*qg[d0*16+hi*8+e];
    #pragma unroll
    for(int sg=0;sg<2;++sg){ const float pos=sg?pcol:prow;
      #pragma unroll
      for(int e=0;e<8;++e){ const float invf=__builtin_amdgcn_exp2f(-(float)(8*hi+e)*0.83048202372184f); const float rev=pos*invf*0.15915494309189535f;
        const float c=__builtin_amdgcn_cosf(rev), s=__builtin_amdgcn_sinf(rev);
        const float x1=xq[2*sg][e], x2=xq[2*sg+1][e]; xq[2*sg][e]=x1*c-x2*s; xq[2*sg+1][e]=x2*c+x1*s; } }
    #pragma unroll
    for(int d0=0;d0<4;++d0){ u32x4 w; w[0]=cvtpk_s(xq[d0][0],xq[d0][1]); w[1]=cvtpk_s(xq[d0][2],xq[d0][3]); w[2]=cvtpk_s(xq[d0][4],xq[d0][5]); w[3]=cvtpk_s(xq[d0][6],xq[d0][7]); qr[d0]=__builtin_bit_cast(bf16x8,w); } }
  float mref; { float a=__builtin_fabsf(qg[lane]), b=__builtin_fabsf(kg[lane]);
    #pragma unroll
    for(int o_=1;o_<64;o_<<=1){ a=__builtin_fmaxf(a,__shfl_xor(a,o_)); b=__builtin_fmaxf(b,__shfl_xor(b,o_)); }
    mref=__builtin_fminf(60.f,11.541560327f*a*b); }
  float l_reg=0.f;f32x16 o[2];o[0]=f32x16{};o[1]=f32x16{};f32x16 negm;
  #pragma unroll
  for(int r=0;r<16;++r)negm[r]=-mref;
  asm volatile("":"+v"(negm));
  const int qrel=wid*QBLK+r32;
  #define CMASK(P0,P1,t) do{}while(0)
  bool resc=false;
  #define START(P0,P1) do{ _Pragma("unroll") for(int r=0;r<16;++r)P0[r]=__builtin_amdgcn_exp2f(P0[r]); }while(0)
  #define RESC() do{ if(resc){ asm volatile("s_waitcnt lgkmcnt(0)":::"memory"); \
      _Pragma("unroll") for(int d_=0;d_<2;++d_) _Pragma("unroll") for(int r=0;r<16;++r)o[d_][r]*=wsf[crow(r,hi)]; } }while(0)
  f32x16 pA0,pA1,pB0,pB1;
  int sl_prev=0,sl_cur=0,sl_next=SLOTB;
  #define ROT() do{sl_prev=sl_cur;sl_cur=sl_next;sl_next=(sl_next==(NSLOT-1)*SLOTB)?0:sl_next+SLOTB;}while(0)
  DMA_K(2,2*SLOTB);
  WAIT_BAR(3);
  qkt(pA0,pA1,Kbase,qr,negm,r32,hi);asm volatile("s_nop 15\n\ts_nop 7":"+v"(pA0),"+v"(pA1));CMASK(pA0,pA1,0);
  START(pA0,pA1);
  _Pragma("unroll") for(int r=0;r<16;++r)pA1[r]=__builtin_amdgcn_exp2f(pA1[r]);
  WAIT_BAR(0);
  DMA_K(3,0);DMA_V(1,SLOTB);
  ROT();
  kload8(kf,kp0+sl_cur);
  WAIT_BAR(2);
  s16x4 vlo[8],vhi[8]; u32x4 pw0,pw1,pw2,pw3;
  #define PKW(P,B) cvtpk_s(P[B],P[B+1])
  #define PAF(k) __builtin_bit_cast(bf16x8,pw##k)
  #define VFR(i) (bf16x8){vlo[i][0],vlo[i][1],vlo[i][2],vlo[i][3],vhi[i][0],vhi[i][1],vhi[i][2],vhi[i][3]}
  #define PIN(x) asm volatile("":"+v"(x))
  #define MX3(a,b,c) __builtin_fmaxf(__builtin_fmaxf((a),(b)),(c))
  #define GAPA(MF,A0,A1,A2,A3,W0,W1,PW) do{ MF; sacc+=A0; sacc+=A1; sacc+=A2; sacc+=A3; PIN(sacc); W0; W1; PIN(PW); SBAR(); }while(0)
  #define EX(v) __builtin_amdgcn_exp2f(v)
  #define GAPB(MF,X,B) do{ MF; X[B]=EX(X[B]); X[B+1]=EX(X[B+1]); X[B+2]=EX(X[B+2]); X[B+3]=EX(X[B+3]); PIN(X); SBAR(); }while(0)
  #define VRD(i) do{ vlo[i]=vtr(vp_+(((i)>>2)*4096+((i)&3)*1024)); vhi[i]=vtr(vp_+(((i)>>2)*4096+((i)&3)*1024+512)); }while(0)
  #define KRD(G,j) do{ if(G){ kload2(kf,kp0+sl_next,j); SBAR(); } }while(0)
  #define STEP(C0,C1,P0,P1,t,GK,GV,GL) do{ SBAR(); \
    const lds_cptr vp_=vp0+sl_prev; \
    VRD(0); SBAR(); float sacc=(P0[0]+P0[1]); \
    GAPA(C0=__builtin_amdgcn_mfma_f32_32x32x16_bf16(kf[0],qr[0],negm,0,0,0), P0[2],P0[3],P0[4],P0[5],     pw0[0]=PKW(P0,0), pw0[1]=PKW(P0,2), pw0); \
    VRD(4); SBAR(); GAPA(C1=__builtin_amdgcn_mfma_f32_32x32x16_bf16(kf[1],qr[0],negm,0,0,0), P0[6],P0[7],P0[8],P0[9],     pw0[2]=PKW(P0,4), pw0[3]=PKW(P0,6), pw0); \
    VRD(1); SBAR(); GAPA(C0=__builtin_amdgcn_mfma_f32_32x32x16_bf16(kf[2],qr[1],C0,0,0,0),   P0[10],P0[11],P0[12],P0[13], pw1[0]=PKW(P0,8), pw1[1]=PKW(P0,10), pw1); \
    VRD(5); SBAR(); GAPA(C1=__builtin_amdgcn_mfma_f32_32x32x16_bf16(kf[3],qr[1],C1,0,0,0),   P0[14],P0[15],P1[0],P1[1],   pw1[2]=PKW(P0,12),pw1[3]=PKW(P0,14), pw1); \
    VRD(2); SBAR(); GAPA(C0=__builtin_amdgcn_mfma_f32_32x32x16_bf16(kf[4],qr[2],C0,0,0,0),   P1[2],P1[3],P1[4],P1[5],     pw2[0]=PKW(P1,0), pw2[1]=PKW(P1,2), pw2); \
    VRD(6); SBAR(); GAPA(C1=__builtin_amdgcn_mfma_f32_32x32x16_bf16(kf[5],qr[2],C1,0,0,0),   P1[6],P1[7],P1[8],P1[9],     pw2[2]=PKW(P1,4), pw2[3]=PKW(P1,6), pw2); \
    VRD(3); SBAR(); GAPA(C0=__builtin_amdgcn_mfma_f32_32x32x16_bf16(kf[6],qr[3],C0,0,0,0),   P1[10],P1[11],P1[12],P1[13], pw3[0]=PKW(P1,8), pw3[1]=PKW(P1,10), pw3); \
    VRD(7); SBAR(); GAPA(C1=__builtin_amdgcn_mfma_f32_32x32x16_bf16(kf[7],qr[3],C1,0,0,0),   P1[14],P1[15],0.f,0.f,       pw3[2]=PKW(P1,12),pw3[3]=PKW(P1,14), pw3); \
    l_reg+=sacc; \
    if(GK){DMA_K((t)+3,sl_cur);} if(GV){DMA_V((t)+1,sl_next);} \
    CMASK(C0,C1,t); \
    SBAR(); \
    GAPB(o[0]=__builtin_amdgcn_mfma_f32_32x32x16_bf16(PAF(0),VFR(0),o[0],0,0,0), C0,0); \
    GAPB(o[1]=__builtin_amdgcn_mfma_f32_32x32x16_bf16(PAF(0),VFR(4),o[1],0,0,0), C0,4); \
    KRD(GL,0); GAPB(o[0]=__builtin_amdgcn_mfma_f32_32x32x16_bf16(PAF(1),VFR(1),o[0],0,0,0), C0,8); \
    KRD(GL,1); GAPB(o[1]=__builtin_amdgcn_mfma_f32_32x32x16_bf16(PAF(1),VFR(5),o[1],0,0,0), C0,12); \
    KRD(GL,2); GAPB(o[0]=__builtin_amdgcn_mfma_f32_32x32x16_bf16(PAF(2),VFR(2),o[0],0,0,0), C1,0); \
    KRD(GL,3); GAPB(o[1]=__builtin_amdgcn_mfma_f32_32x32x16_bf16(PAF(2),VFR(6),o[1],0,0,0), C1,4); \
    GAPB(o[0]=__builtin_amdgcn_mfma_f32_32x32x16_bf16(PAF(3),VFR(3),o[0],0,0,0), C1,8); \
    GAPB(o[1]=__builtin_amdgcn_mfma_f32_32x32x16_bf16(PAF(3),VFR(7),o[1],0,0,0), C1,12); \
    }while(0)
  int t=1;
  #undef CMASK
  #define CMASK(P0,P1,t) do{}while(0)
  for(;t+5<NT;t+=2){
    STEP(pB0,pB1,pA0,pA1,t,true,true,true);     WAIT_BAR(2); RESC(); ROT();
    STEP(pA0,pA1,pB0,pB1,t+1,true,true,true);   WAIT_BAR(2); RESC(); ROT();
  }
  #undef CMASK
  #define CMASK(P0,P1,t) do{}while(0)
  #define ENDW(tt) do{ if((tt)+3<NT){WAIT_BAR(2);} else if((tt)+2<NT){WAIT_BAR(1);} else {WAIT_BAR(0);} }while(0)
  for(;t+1<NT;t+=2){
    STEP(pB0,pB1,pA0,pA1,t,(t+3<NT),(t+1<NT),(t+1<NT));       ENDW(t);   RESC(); ROT();
    STEP(pA0,pA1,pB0,pB1,t+1,(t+4<NT),(t+2<NT),(t+2<NT));     ENDW(t+1); RESC(); ROT();
  }
  STEP(pB0,pB1,pA0,pA1,NT-1,false,false,false); RESC();
  { float sacc=pB0[0]+pB0[1]; _Pragma("unroll") for(int r=2;r<16;++r)sacc+=pB0[r]; _Pragma("unroll") for(int r=0;r<16;++r)sacc+=pB1[r]; l_reg+=sacc;
    pw0=(u32x4){PKW(pB0,0),PKW(pB0,2),PKW(pB0,4),PKW(pB0,6)};pw1=(u32x4){PKW(pB0,8),PKW(pB0,10),PKW(pB0,12),PKW(pB0,14)};pw2=(u32x4){PKW(pB1,0),PKW(pB1,2),PKW(pB1,4),PKW(pB1,6)};pw3=(u32x4){PKW(pB1,8),PKW(pB1,10),PKW(pB1,12),PKW(pB1,14)};
    SBAR(); pv(o,vb0+sl_cur,PAF(0),PAF(1),PAF(2),PAF(3)); }
  #undef PKW
  #undef PAF
  #undef VFR
  #undef PIN
  #undef MX3
  #undef GAPA
  #undef GAPB
  #undef EX
  #undef VRD
  #undef KRD
  #undef STEP
  #undef ENDW
  {auto rr=__builtin_amdgcn_permlane32_swap(__float_as_uint(l_reg),__float_as_uint(l_reg),false,false);l_reg=__uint_as_float(rr[0])+__uint_as_float(rr[1]);}
  if(hi==0)wsf[32+r32]=l_reg;asm volatile("s_waitcnt lgkmcnt(0)":::"memory");
  float rli[16];
  #pragma unroll
  for(int r=0;r<16;++r)rli[r]=__builtin_amdgcn_rcpf(wsf[32+crow(r,hi)]);
  bf16*Ow=O+(rowbase+q0+wid*QBLK)*OP+h*D;
  { bf16*stg=(bf16*)(shm+LDS_OST)+wid*2048;
    #pragma unroll
    for(int r=0;r<16;++r){const int orow=crow(r,hi);
      #pragma unroll
      for(int d0=0;d0<2;++d0)stg[orow*64+d0*32+r32]=__float2bfloat16(o[d0][r]*rli[r]);}
    asm volatile("s_waitcnt lgkmcnt(0)":::"memory");
    #pragma unroll
    for(int i=0;i<4;++i){const int row=i*8+(lane>>3),ch=lane&7; const u32x4 v=*(const u32x4*)(stg+row*64+ch*8); ATTN_STORE16(Ow+(long)row*OP+ch*8,v);
      float sq=0.f;
      #pragma unroll
      for(int e=0;e<4;++e){ const float lo=__uint_as_float(v[e]<<16), hh=__uint_as_float(v[e]&0xffff0000u); sq+=lo*lo+hh*hh; }
      sq+=__shfl_xor(sq,1); sq+=__shfl_xor(sq,2); sq+=__shfl_xor(sq,4);
      if(ch==0) fx_atomic_add(ssq+4*(rowbase+q0+wid*QBLK+row), fx_from(sq,FX_SQ)); } }
  asm volatile("s_waitcnt lgkmcnt(0)\n\ts_barrier":::"memory");
  #undef DMA_K
  #undef DMA_V
  #undef CMASK
  #undef START
  #undef RESC
  #undef ROT
}

__device__ __forceinline__ void q_frags(bf16x8*qr,const bf16*Qrow,const float*__restrict__ qg,int tq,int hi){
  float xq[4][8]; float ss=0.f;
  #pragma unroll
  for(int d0=0;d0<4;++d0){ const bf16x8 raw=*reinterpret_cast<const bf16x8*>(&Qrow[d0*16+hi*8]);
    #pragma unroll
    for(int e=0;e<8;++e){ const float v=__builtin_bit_cast(float,((unsigned)(unsigned short)raw[e])<<16); xq[d0][e]=v; ss+=v*v; } }
  { auto rr=__builtin_amdgcn_permlane32_swap(__float_as_uint(ss),__float_as_uint(ss),false,false); ss=__uint_as_float(rr[0])+__uint_as_float(rr[1]); }
  const float rstd=C2/sqrtf(ss*(1.0f/64.0f)+1e-6f);
  const float prow=(float)(tq>>6), pcol=(float)(tq&63);
  #pragma unroll
  for(int d0=0;d0<4;++d0)
    #pragma unroll
    for(int e=0;e<8;++e) xq[d0][e]*=rstd*qg[d0*16+hi*8+e];
  #pragma unroll
  for(int sg=0;sg<2;++sg){ const float pos=sg?pcol:prow;
    #pragma unroll
    for(int e=0;e<8;++e){ const float invf=__builtin_amdgcn_exp2f(-(float)(8*hi+e)*0.83048202372184f); const float rev=pos*invf*0.15915494309189535f;
      const float c=__builtin_amdgcn_cosf(rev), s=__builtin_amdgcn_sinf(rev);
      const float x1=xq[2*sg][e], x2=xq[2*sg+1][e]; xq[2*sg][e]=x1*c-x2*s; xq[2*sg+1][e]=x2*c+x1*s; } }
  #pragma unroll
  for(int d0=0;d0<4;++d0){ u32x4 w; w[0]=cvtpk_s(xq[d0][0],xq[d0][1]); w[1]=cvtpk_s(xq[d0][2],xq[d0][3]); w[2]=cvtpk_s(xq[d0][4],xq[d0][5]); w[3]=cvtpk_s(xq[d0][6],xq[d0][7]); qr[d0]=__builtin_bit_cast(bf16x8,w); }
}
constexpr int A64_LDS_V=NSLOT*SLOTB;
__device__ __forceinline__ void glds16s(const void*sbase,unsigned voff,unsigned lds_dst){unsigned keep;
  asm volatile("s_mov_b32 %0, m0\n\ts_mov_b32 m0, %3\n\ts_nop 0\n\tglobal_load_lds_dwordx4 %1, %2\n\ts_mov_b32 m0, %0":"=&s"(keep):"v"(voff),"s"(sbase),"s"(lds_dst):"memory");}
__device__ __forceinline__ void attn_unit64(int b,int h,int qb,const bf16*Q,const bf16*__restrict__ K,const bf16*__restrict__ V,bf16*O,char*shm,const float*__restrict__ qg,const float*__restrict__ kg,fx_t*ssq,int wid_s){
  int tid_; asm volatile("v_mbcnt_lo_u32_b32 %0, -1, 0\n\tv_mbcnt_hi_u32_b32 %0, -1, %0\n\tv_lshl_or_b32 %0, %1, 6, %0":"=&v"(tid_):"s"(wid_s)); const int tid=tid_,lane=tid&63,r32=lane&31,hi=lane>>5; const int wid=wid_s;
  const long rowbase=(long)b*SEQ; const int q0=qb*512+wid*64;
  const bf16*Kh=K+rowbase*KP+(h>>1)*D,*Vh=V+rowbase*VP+(h>>1)*D;
  const unsigned lds0=(unsigned)(uintptr_t)shm;
  const unsigned koff=(unsigned)((lane*KP+wid*8)*2);
  const unsigned voff=(unsigned)(((16*(wid&3)+(lane>>2))*VP+(wid>>2)*32+(lane&3)*8)*2);
  constexpr int S2B=2*SLOTB, LDSV2=3*S2B;
  const unsigned kdst=lds0+wid*1024, vdst=lds0+LDSV2+wid*1024;
  #define DMA64(t,slot) do{ glds16s(Kh+(long)(2*(t))*KVBLK*KP,koff,(unsigned)__builtin_amdgcn_readfirstlane(kdst+(slot))); glds16s(Kh+(long)(2*(t)+1)*KVBLK*KP,koff,(unsigned)__builtin_amdgcn_readfirstlane(kdst+(slot)+SLOTB)); \
    glds16s(Vh+(long)(2*(t))*KVBLK*VP,voff,(unsigned)__builtin_amdgcn_readfirstlane(vdst+(slot))); glds16s(Vh+(long)(2*(t)+1)*KVBLK*VP,voff,(unsigned)__builtin_amdgcn_readfirstlane(vdst+(slot)+SLOTB)); }while(0)
  const lds_cptr shm3=(lds_cptr)shm; const lds_cptr kp0=shm3+hi*1024+r32*16; const lds_cptr vp0=shm3+LDSV2+((lane>>4)&1)*32+(lane&3)*8+(4*hi+((lane&15)>>2))*64;
  bf16x8 q0f[4],q1f[4];
  q_frags(q0f,Q+(rowbase+q0+r32)*QP+h*D,qg,q0+r32,hi); asm volatile("":"+v"(q0f[0]),"+v"(q0f[1]),"+v"(q0f[2]),"+v"(q0f[3])); SBAR();
  q_frags(q1f,Q+(rowbase+q0+32+r32)*QP+h*D,qg,q0+32+r32,hi); asm volatile("":"+v"(q1f[0]),"+v"(q1f[1]),"+v"(q1f[2]),"+v"(q1f[3])); SBAR();
  constexpr int NT=SEQ/(2*KVBLK);
  DMA64(0,0); DMA64(1,S2B);
  const f32x16 zero16=f32x16{};
  f32x16 ot00=f32x16{},ot01=f32x16{},ot10=f32x16{},ot11=f32x16{}; float l0=0.f,l1=0.f;
  asm volatile("s_waitcnt vmcnt(0)\n\ts_barrier":::"memory");
  typedef const __attribute__((address_space(3))) bf16x8* kfp_t;
  #define KLD(dst,base) do{ dst[0]=*(kfp_t)((base)); dst[1]=*(kfp_t)((base)+2048); dst[2]=*(kfp_t)((base)+4096); dst[3]=*(kfp_t)((base)+6144); }while(0)
  #define EX4(S,B) do{ S[B]=__builtin_amdgcn_exp2f(S[B]); S[B+1]=__builtin_amdgcn_exp2f(S[B+1]); S[B+2]=__builtin_amdgcn_exp2f(S[B+2]); S[B+3]=__builtin_amdgcn_exp2f(S[B+3]); }while(0)
  #define PK8(S,B) (u32x4){cvtpk_s(S[B],S[B+1]),cvtpk_s(S[B+2],S[B+3]),cvtpk_s(S[B+4],S[B+5]),cvtpk_s(S[B+6],S[B+7])}
  #define SUM4(A,S,B) do{ A+=(S[B]+S[B+1])+(S[B+2]+S[B+3]); }while(0)
  #define MF(a,b,c) __builtin_amdgcn_mfma_f32_32x32x16_bf16(a,b,c,0,0,0)
  #define VF(lo,hi_) (bf16x8){lo[0],lo[1],lo[2],lo[3],hi_[0],hi_[1],hi_[2],hi_[3]}
  #define HALFSTEP(SC0,SC1,SN0,SN1,VP_,KS,KNEXT) do{ \
    const s16x4 v0l=vtr((VP_)+(KS)*1024), v0h=vtr((VP_)+(KS)*1024+512), v1l=vtr((VP_)+4096+(KS)*1024), v1h=vtr((VP_)+4096+(KS)*1024+512); SBAR(); \
    SN0=MF(kf[0],q0f[0],zero16); EX4(SC0,0);  SBAR(); \
    SN1=MF(kf[0],q1f[0],zero16); EX4(SC0,4);  SBAR(); \
    SN0=MF(kf[1],q0f[1],SN0);  EX4(SC0,8);  SBAR(); \
    SN1=MF(kf[1],q1f[1],SN1);  EX4(SC0,12); SBAR(); \
    SN0=MF(kf[2],q0f[2],SN0);  EX4(SC1,0);  SBAR(); \
    SN1=MF(kf[2],q1f[2],SN1);  EX4(SC1,4);  SBAR(); \
    SN0=MF(kf[3],q0f[3],SN0);  EX4(SC1,8);  SBAR(); \
    SN1=MF(kf[3],q1f[3],SN1);  EX4(SC1,12); SBAR(); \
    const bf16x8 p00=__builtin_bit_cast(bf16x8,PK8(SC0,0)), p10=__builtin_bit_cast(bf16x8,PK8(SC1,0)); SUM4(l0,SC0,0); SUM4(l0,SC0,4); SUM4(l1,SC1,0); SUM4(l1,SC1,4); SBAR(); \
    ot00=MF(VF(v0l,v0h),p00,ot00); \
    const s16x4 v2l=vtr((VP_)+((KS)+1)*1024), v2h=vtr((VP_)+((KS)+1)*1024+512), v3l=vtr((VP_)+4096+((KS)+1)*1024), v3h=vtr((VP_)+4096+((KS)+1)*1024+512); SBAR(); \
    ot10=MF(VF(v0l,v0h),p10,ot10); SUM4(l0,SC0,8); SUM4(l0,SC0,12); SBAR(); \
    ot01=MF(VF(v1l,v1h),p00,ot01); SUM4(l1,SC1,8); SUM4(l1,SC1,12); SBAR(); \
    ot11=MF(VF(v1l,v1h),p10,ot11); const bf16x8 p01=__builtin_bit_cast(bf16x8,PK8(SC0,8)), p11=__builtin_bit_cast(bf16x8,PK8(SC1,8)); SBAR(); \
    ot00=MF(VF(v2l,v2h),p01,ot00); SBAR(); \
    ot10=MF(VF(v2l,v2h),p11,ot10); KLD(kf,KNEXT); SBAR(); \
    ot01=MF(VF(v3l,v3h),p01,ot01); SBAR(); \
    ot11=MF(VF(v3l,v3h),p11,ot11); SBAR(); \
  }while(0)
  bf16x8 kf[4]; f32x16 sA0,sA1,sB0,sB1;
  KLD(kf,kp0);
  sA0=zero16; sA1=zero16;
  #pragma unroll
  for(int d0=0;d0<4;++d0){ sA0=MF(kf[d0],q0f[d0],sA0); sA1=MF(kf[d0],q1f[d0],sA1); }
  SBAR(); KLD(kf,kp0+512); SBAR();
  int sl=0;
  #pragma unroll 1
  for(int t=0;t<NT;++t){
    asm volatile("s_waitcnt vmcnt(0) lgkmcnt(0)\n\ts_barrier":::"memory");
    const int sl1=(sl==2*S2B)?0:sl+S2B;
    if(t+2<NT) DMA64(t+2,((sl>=S2B)?sl-S2B:sl+2*S2B));
    const lds_cptr vp=vp0+sl;
    #define kc (kp0+sl)
    #define kn (kp0+sl1)
    HALFSTEP(sA0,sA1,sB0,sB1,vp,0,kc+SLOTB);
    HALFSTEP(sB0,sB1,sA0,sA1,vp,2,kc+SLOTB+512);
    HALFSTEP(sA0,sA1,sB0,sB1,vp+SLOTB,0,kn);
    HALFSTEP(sB0,sB1,sA0,sA1,vp+SLOTB,2,kn+512);
    #undef kc
    #undef kn
    sl=sl1;
  }
  asm volatile("s_waitcnt vmcnt(0) lgkmcnt(0)\n\ts_barrier":::"memory");
  #undef HALFSTEP
  #undef KLD
  #undef EX4
  #undef PK8
  #undef SUM4
  #undef MF
  #undef VF
  #undef DMA64
  int te_; asm volatile("v_mbcnt_lo_u32_b32 %0, -1, 0\n\tv_mbcnt_hi_u32_b32 %0, -1, %0":"=&v"(te_)); const int r32e=te_&31, hie=te_>>5;
  l0+=__shfl_xor(l0,32); l1+=__shfl_xor(l1,32);
  const float i0=__builtin_amdgcn_rcpf(l0), i1=__builtin_amdgcn_rcpf(l1);
  typedef unsigned u32x2 __attribute__((ext_vector_type(2)));
  #define ST64(OT,INV,ROWOFF,DT,SQ) do{ bf16*op_=O+(rowbase+q0+(ROWOFF)+r32e)*OP+h*D+32*(DT)+4*hie; \
    _Pragma("unroll") for(int rg=0;rg<4;++rg){ u32x2 w_; w_[0]=cvtpk_s(OT[4*rg]*INV,OT[4*rg+1]*INV); w_[1]=cvtpk_s(OT[4*rg+2]*INV,OT[4*rg+3]*INV); *(u32x2*)(op_+8*rg)=w_; \
      const float e0=__uint_as_float(w_[0]<<16),e1=__uint_as_float(w_[0]&0xffff0000u),e2=__uint_as_float(w_[1]<<16),e3=__uint_as_float(w_[1]&0xffff0000u); SQ+=(e0*e0+e1*e1)+(e2*e2+e3*e3); } }while(0)
  float sq0=0.f,sq1=0.f;
  ST64(ot00,i0,0,0,sq0); ST64(ot01,i0,0,1,sq0); ST64(ot10,i1,32,0,sq1); ST64(ot11,i1,32,1,sq1);
  #undef ST64
  sq0+=__shfl_xor(sq0,32); sq1+=__shfl_xor(sq1,32);
  if(hie==0){ fx_atomic_add(ssq+4*(rowbase+q0+r32e),fx_from(sq0,FX_SQ)); fx_atomic_add(ssq+4*(rowbase+q0+32+r32e),fx_from(sq1,FX_SQ)); }
}
constexpr int ATTN_LDS_BYTES=LDS_BYTES;
#undef SBAR
#undef WAIT_BAR
}
namespace mk {
#define LAS __attribute__((address_space(3)))
typedef unsigned short bf16;
typedef unsigned v4u __attribute__((ext_vector_type(4)));
typedef unsigned v2u __attribute__((ext_vector_type(2)));
typedef float f32x4 __attribute__((ext_vector_type(4)));
typedef float f32x16 __attribute__((ext_vector_type(16)));
typedef short bf16x8 __attribute__((ext_vector_type(8)));
typedef short s16x4 __attribute__((ext_vector_type(4)));

constexpr int BATCH = 2, SEQ = 16384, DM = 1024, T = BATCH * SEQ, DEPTH = 2, FF = 4096;
constexpr int NP = 2048;
constexpr int C_AQ = 0, C_AK = 256, C_AV = 384, C_BU = 512, C_BB = 768, C_BC = 1024, C_CU = 1280, C_DQ = 1536, C_DK = 1792, C_DV = 1920;
constexpr float LN_EPS = 1e-5f, RMS_EPS = 1e-6f;
constexpr float DN_ALPHA = 1.41421356237f;
constexpr float LOG2E = 1.4426950408889634f;
constexpr int NWAVES = 8;

constexpr size_t MiB = 1u << 20;
constexpr size_t WS_CS = 16 * 1024, CS_LAYER = 12800  , WS_ZERO_BYTES = 256 * 1024;
constexpr size_t WS_CSF = 512 * 1024  ;
constexpr size_t WS_TAB1 = 1792 * 1024, WS_TAB2 = 1920 * 1024, WS_TAB0 = 1984 * 1024;
constexpr size_t WS_W = 2 * MiB, W_LAYER = 23 * MiB, W_IN = 0, W_OUT = 5 * MiB, W_1 = 7 * MiB, W_2 = 15 * MiB;
constexpr size_t WS_HB = 48 * MiB;
constexpr size_t WS_PROJ = 112 * MiB, WS_QD = 256 * MiB, WS_KD = 272 * MiB, WS_Z = 280 * MiB, WS_MIX = 312 * MiB, WS_ACT = 112 * MiB, WS_SSQ = 376 * MiB  , WS_ST = 378 * MiB, WS_ZERO2_BYTES = 4 * MiB  , WS_END = 381 * MiB;

constexpr int LDS_BYTES = 147456, RING_BYTES = 131072;

struct Args {
    const float* x; const float* ln_in_g; const float* ln_in_b; const float* w_in; const float* conv_w; const float* sink; const float* qn_g; const float* kn_g;
    const float* grp_g; const float* w_out; const float* ln1_g; const float* ln1_b; const float* w1; const float* w2; const float* ln2_g; const float* ln2_b;
    float* out; unsigned char* ws;
};

__device__ __forceinline__ unsigned f2bf(float f) { unsigned u = __builtin_bit_cast(unsigned, f); return (u + 0x7fffu + ((u >> 16) & 1u)) >> 16; }
__device__ __forceinline__ unsigned pk2(float lo, float hi) { return f2bf(lo) | (f2bf(hi) << 16); }
__device__ __forceinline__ unsigned hwpk2(float lo, float hi) { typedef float f2_t __attribute__((ext_vector_type(2))); typedef __bf16 b2_t __attribute__((ext_vector_type(2))); f2_t v = {lo, hi}; b2_t b = __builtin_convertvector(v, b2_t); return __builtin_bit_cast(unsigned, b); }
__device__ __forceinline__ float bf2f(unsigned short b) { return __builtin_bit_cast(float, (unsigned)b << 16); }
__device__ __forceinline__ float bflo(unsigned w) { return __builtin_bit_cast(float, w << 16); }
__device__ __forceinline__ float bfhi(unsigned w) { return __builtin_bit_cast(float, w & 0xffff0000u); }
__device__ __forceinline__ float wave_sum(float v) {
    const int l = mk_lane();
#pragma unroll
    for (int o = 1; o < 64; o <<= 1) v += mk_shfl_xor_l(v, o, l);
    return v;
}
__device__ __forceinline__ float hw_cos(float rev) { return __builtin_amdgcn_cosf(rev); }
__device__ __forceinline__ float hw_sin(float rev) { return __builtin_amdgcn_sinf(rev); }
__device__ __forceinline__ int otid_(int wid_s) { int t; asm volatile("v_mbcnt_lo_u32_b32 %0, -1, 0\n\tv_mbcnt_hi_u32_b32 %0, -1, %0\n\tv_lshl_or_b32 %0, %1, 6, %0" : "=&v"(t) : "s"(wid_s)); return t; }
#define otid() otid_(wid_s)
#define obx() ({ int b_ = bx; asm volatile("" : "+s"(b_)); b_; })
#define ovcu() ({ int v_ = vcu; asm volatile("" : "+s"(v_)); v_; })
__device__ __forceinline__ int crow(int r, int hi) { return (r & 3) + 8 * (r >> 2) + 4 * hi; }

#define XB_TMO      128
#define XB_XCNT(j)  (256  + 64 * (j))
#define XB_XSUB(j)  (1280 + 64 * (j))
#define XB_XGEN(j)  (2304 + 64 * (j))
#define XB_TOP      3328
#define XB_TOPGEN   3392
#define XCD_BAR_WORDS 3456
#define XB_SPIN_CAP (1u << 18)

__device__ __forceinline__ unsigned xb_ld(unsigned* p)              { return __hip_atomic_load(p, __ATOMIC_RELAXED, __HIP_MEMORY_SCOPE_AGENT); }
__device__ __forceinline__ unsigned xb_add(unsigned* p, unsigned v) { return __hip_atomic_fetch_add(p, v, __ATOMIC_RELAXED, __HIP_MEMORY_SCOPE_AGENT); }
__device__ __forceinline__ unsigned xb_xcc_id() { return (unsigned)__builtin_amdgcn_s_getreg((3 << 11) | 20) & 0xFu; }
#define XB_SPIN(cond, bar) do { unsigned _sp = 0; while (cond) { __builtin_amdgcn_s_sleep(1); \
    if ((++_sp & 255u) == 0u) { if (xb_ld(&(bar)[XB_TMO])) break; if (_sp > XB_SPIN_CAP) { atomicAdd(&(bar)[XB_TMO], 1u); break; } } } } while (0)

struct XcdBarrier {
    unsigned* bar; unsigned x;
    volatile LAS unsigned* st;
};

__device__ __forceinline__ XcdBarrier xcd_barrier_post(unsigned* bar, volatile LAS unsigned* st) {
    XcdBarrier b; b.bar = bar; b.x = xb_xcc_id(); b.st = st;
    if (threadIdx.x == 0) (void)xb_add(&bar[XB_XCNT(b.x)], 1u);
    return b;
}
__device__ __forceinline__ void xcd_barrier_complete(unsigned* bar, unsigned x, unsigned& nloc, unsigned& nx) {
    const unsigned G = gridDim.x * gridDim.y * gridDim.z;
    unsigned sum, cnt, mine, sp = 0u;
    for (;;) {
        sum = 0u; cnt = 0u; mine = 0u;
#pragma unroll
        for (unsigned j = 0; j < 16; ++j) { const unsigned c = xb_ld(&bar[XB_XCNT(j)]); sum += c; cnt += (c > 0u) ? 1u : 0u; mine = (j == x) ? c : mine; }
        if (sum == G) break;
        __builtin_amdgcn_s_sleep(1);
        if ((++sp & 255u) == 0u) { if (xb_ld(&bar[XB_TMO])) break; if (sp > XB_SPIN_CAP) { atomicAdd(&bar[XB_TMO], 1u); break; } }
    }
    nloc = mine > 0u ? mine : 1u; nx = cnt > 0u ? cnt : 1u;
}

__device__ __forceinline__ void xcd_barrier(const XcdBarrier& b) {
    asm volatile("s_waitcnt vmcnt(0)" ::: "memory");
    __syncthreads();
    if (threadIdx.x == 0) {
        unsigned* bar = b.bar;
        __builtin_amdgcn_s_waitcnt(0);
        unsigned nloc = b.st[0], nx = b.st[1];
        if (nloc == 0u) { xcd_barrier_complete(bar, b.x, nloc, nx); b.st[0] = nloc; b.st[1] = nx; }
        const unsigned old = xb_add(&bar[XB_XSUB(b.x)], 1u);
        const unsigned gen = old / nloc;
        if (old + 1u == (gen + 1u) * nloc) {
            __builtin_amdgcn_fence(__ATOMIC_RELEASE, "agent");
            asm volatile("s_waitcnt vmcnt(0)" ::: "memory");
            const unsigned og = xb_add(&bar[XB_TOP], 1u);
            const unsigned tg = og / nx;
            if (og + 1u == (tg + 1u) * nx) xb_add(&bar[XB_TOPGEN], 1u);
            else XB_SPIN(xb_ld(&bar[XB_TOPGEN]) == tg, bar);
            __builtin_amdgcn_fence(__ATOMIC_ACQUIRE, "agent");
            xb_add(&bar[XB_XGEN(b.x)], 1u);
            asm volatile("s_waitcnt vmcnt(0)" ::: "memory");
        } else {
            XB_SPIN(xb_ld(&bar[XB_XGEN(b.x)]) == gen, bar);
            __builtin_amdgcn_fence(__ATOMIC_ACQUIRE, "agent");
            asm volatile("s_waitcnt vmcnt(0)" ::: "memory");
        }
    }
    __syncthreads();
}

__device__ __forceinline__ void transpose_item(const float* W, int K, int N, bf16* WT, int k0, int n0, int drow0, LAS float* scr, int lane, const float* gk = nullptr, const float* bk = nullptr, fx_t* cs = nullptr, fx_t* bw = nullptr) {
    { float wv[32];
#pragma unroll
      for (int i = 0; i < 32; ++i) wv[i] = W[(size_t)(k0 + 2 * i + (lane >> 5)) * N + n0 + (lane & 31)];
#pragma unroll
      for (int i = 0; i < 32; ++i) scr[(2 * i + (lane >> 5)) * 33 + (lane & 31)] = wv[i]; }
    asm volatile("s_waitcnt lgkmcnt(0)" ::: "memory");
    const int c = lane & 7;
    float gg[8];
#pragma unroll
    for (int j = 0; j < 8; ++j) gg[j] = gk ? gk[k0 + 8 * c + j] : 1.0f;
#pragma unroll
    for (int j = 0; j < 4; ++j) { const int n = (lane >> 3) + 8 * j; const LAS float* s = scr + (8 * c) * 33 + n;
        v4u o; o.x = hwpk2(s[0 * 33] * gg[0], s[1 * 33] * gg[1]); o.y = hwpk2(s[2 * 33] * gg[2], s[3 * 33] * gg[3]); o.z = hwpk2(s[4 * 33] * gg[4], s[5 * 33] * gg[5]); o.w = hwpk2(s[6 * 33] * gg[6], s[7 * 33] * gg[7]);
        *(v4u*)(WT + (size_t)(drow0 + n) * K + k0 + 8 * c) = o; }
    if (cs) {
        const int n = lane & 31, kh = lane >> 5; float a0 = 0.f, a1 = 0.f;
#pragma unroll
        for (int i = 0; i < 32; ++i) { const int kk = 32 * kh + i; const float w = scr[kk * 33 + n]; a0 += bf2f((unsigned short)f2bf(w * gk[k0 + kk])); a1 += w * bk[k0 + kk]; }
        a0 += __shfl_xor(a0, 32); a1 += __shfl_xor(a1, 32);
        if (lane < 32) { fx_atomic_add(cs + drow0 + n, fx_from(a0, FX_CS)); fx_atomic_add(bw + drow0 + n, fx_from(a1, FX_CS)); }
    }
    asm volatile("s_waitcnt lgkmcnt(0)" ::: "memory");
}
__device__ __forceinline__ void row_to_y(const float* xrow, bf16* yrow, fx_t* st, int lane) {
    const f32x4* xr = (const f32x4*)xrow + lane; v2u* o2 = (v2u*)yrow + lane; float s = 0.f, q = 0.f;
#pragma unroll
    for (int j = 0; j < 4; ++j) { const f32x4 v = xr[64 * j]; v2u w; w.x = hwpk2(v.x, v.y); w.y = hwpk2(v.z, v.w); o2[64 * j] = w;
        const float r0 = bflo(w.x), r1 = bfhi(w.x), r2 = bflo(w.y), r3 = bfhi(w.y); s += (r0 + r1) + (r2 + r3); q += (r0 * r0 + r1 * r1) + (r2 * r2 + r3 * r3); }
    s = wave_sum(s); q = wave_sum(q);
    if (lane == 0) st[0] = st_pack(s, q);
}
__device__ __forceinline__ void y_to_out(const bf16* yrow, const fx_t* st, const float* g, const float* b, float* orow, int lane) {
    float s_, q_; st_unpack(st[0], s_, q_); const float mean = s_ * (1.f / DM), rstd = 1.f / sqrtf(q_ * (1.f / DM) - mean * mean + LN_EPS);
    const v2u* y2 = (const v2u*)yrow + lane; f32x4* o4 = (f32x4*)orow + lane;
#pragma unroll
    for (int j = 0; j < 4; ++j) { const v2u w = y2[64 * j]; const f32x4 gg = ((const f32x4*)g)[lane + 64 * j], bb = ((const f32x4*)b)[lane + 64 * j];
        const f32x4 y = (f32x4){bflo(w.x), bfhi(w.x), bflo(w.y), bfhi(w.y)}; o4[64 * j] = (y - mean) * rstd * gg + bb; }
}
__device__ __forceinline__ void ln_row(const float* xrow, const float* g, const float* b, float* orow, bf16* brow, int lane) {
    const f32x4* xr = (const f32x4*)xrow + lane;
    f32x4 v[4]; float s = 0.f;
#pragma unroll
    for (int j = 0; j < 4; ++j) { v[j] = xr[64 * j]; s += (v[j].x + v[j].y) + (v[j].z + v[j].w); }
    const float mean = wave_sum(s) * (1.f / DM); float s2 = 0.f;
#pragma unroll
    for (int j = 0; j < 4; ++j) { v[j] = v[j] - mean; s2 += (v[j].x * v[j].x + v[j].y * v[j].y) + (v[j].z * v[j].z + v[j].w * v[j].w); }
    const float rstd = 1.f / sqrtf(wave_sum(s2) * (1.f / DM) + LN_EPS);
    f32x4* o4 = (f32x4*)orow + lane; v2u* o2 = (v2u*)brow + lane;
#pragma unroll
    for (int j = 0; j < 4; ++j) { const f32x4 gg = ((const f32x4*)g)[lane + 64 * j], bb = ((const f32x4*)b)[lane + 64 * j];
        const f32x4 y = v[j] * rstd * gg + bb; o4[64 * j] = y; v2u w; w.x = pk2(y.x, y.y); w.y = pk2(y.z, y.w); o2[64 * j] = w; }
}

template <int NB> __device__ __forceinline__ void prep_k_tokens(const bf16* proj, const float* kg, bf16* KD, int t0, int tstride, int lane) {
    const int seg = lane >> 5, j = lane & 15, half = (lane >> 4) & 1;
    const float invf = exp2f(-(float)j * 0.83048202372184f) * 0.15915494309189535f;
    const float gk = kg[lane];
    float x[NB][2];
#pragma unroll
    for (int u = 0; u < NB; ++u) { const int t = t0 + u * tstride; const bf16* pr = proj + (size_t)(t < T ? t : 0) * NP + C_DK + lane; x[u][0] = bf2f(pr[0]); x[u][1] = bf2f(pr[64]); }
#pragma unroll
    for (int u = 0; u < NB; ++u) { const int t = t0 + u * tstride; if (t >= T) break;
        const int tin = t & (SEQ - 1); const float pos = (float)(seg ? (tin & 63) : (tin >> 6));
        const float rev = pos * invf; const float c = hw_cos(rev), s = hw_sin(rev);
#pragma unroll
        for (int hh = 0; hh < 2; ++hh) {
            const float ss = wave_sum(x[u][hh] * x[u][hh]);
            const float xn = x[u][hh] * (1.f / sqrtf(ss * (1.f / 64.f) + RMS_EPS)) * gk;
            const float xp = __shfl_xor(xn, 16);
            const float o = half ? (xn * c + xp * s) : (xn * c - xp * s);
            KD[(size_t)t * 128 + hh * 64 + lane] = (bf16)f2bf(o);
        } }
}
template <int NB> __device__ __forceinline__ void conv_tokens(const bf16* proj, const float* cw  , bf16* mix, fx_t* ssq, int t0, int tstride, int lane) {
    const f32x4 w0 = ((const f32x4*)cw)[lane], w1 = ((const f32x4*)(cw + 256))[lane], w2 = ((const f32x4*)(cw + 512))[lane];
    v2u u0[NB], g0[NB], u1[NB], g1[NB], u2[NB], g2[NB], gb[NB];
#pragma unroll
    for (int u = 0; u < NB; ++u) { const int t = t0 + u * tstride, tc = t < T ? t : 0, tin = tc & (SEQ - 1);
        const bf16* pr = proj + (size_t)tc * NP + 4 * lane;
        u1[u] = *(const v2u*)(pr + C_BU); gb[u] = *(const v2u*)(pr + C_BB); g1[u] = *(const v2u*)(pr + C_BC);
        u0[u] = (v2u){0u, 0u}; g0[u] = u0[u]; u2[u] = u0[u]; g2[u] = u0[u];
        if (tin > 0) { u0[u] = *(const v2u*)(pr - NP + C_BU); g0[u] = *(const v2u*)(pr - NP + C_BC); }
        if (tin < SEQ - 1) { u2[u] = *(const v2u*)(pr + NP + C_BU); g2[u] = *(const v2u*)(pr + NP + C_BC); } }
#pragma unroll
    for (int u = 0; u < NB; ++u) { const int t = t0 + u * tstride; if (t >= T) break;
        float y[4];
        y[0] = bflo(gb[u].x) * (w0.x * (bflo(u0[u].x) * bflo(g0[u].x)) + w1.x * (bflo(u1[u].x) * bflo(g1[u].x)) + w2.x * (bflo(u2[u].x) * bflo(g2[u].x)));
        y[1] = bfhi(gb[u].x) * (w0.y * (bfhi(u0[u].x) * bfhi(g0[u].x)) + w1.y * (bfhi(u1[u].x) * bfhi(g1[u].x)) + w2.y * (bfhi(u2[u].x) * bfhi(g2[u].x)));
        y[2] = bflo(gb[u].y) * (w0.z * (bflo(u0[u].y) * bflo(g0[u].y)) + w1.z * (bflo(u1[u].y) * bflo(g1[u].y)) + w2.z * (bflo(u2[u].y) * bflo(g2[u].y)));
        y[3] = bfhi(gb[u].y) * (w0.w * (bfhi(u0[u].y) * bfhi(g0[u].y)) + w1.w * (bfhi(u1[u].y) * bfhi(g1[u].y)) + w2.w * (bfhi(u2[u].y) * bfhi(g2[u].y)));
        v2u o; o.x = pk2(y[0], y[1]); o.y = pk2(y[2], y[3]);
        *(v2u*)(mix + (size_t)t * DM + 256 + 4 * lane) = o;
        const float r0 = bflo(o.x), r1 = bfhi(o.x), r2 = bflo(o.y), r3 = bfhi(o.y); const float sq = wave_sum((r0 * r0 + r1 * r1) + (r2 * r2 + r3 * r3));
        if (lane == 0) ssq[4 * (size_t)t + 1] = fx_from(sq, FX_SQ); }
}
__device__ __forceinline__ void grpnorm_token(bf16* mix, const float* gg, int t, int lane) {
    v4u* p = (v4u*)(mix + (size_t)t * DM + 16 * lane);
    const v4u a = p[0], b = p[1];
    float v[16];
    v[0] = bflo(a.x); v[1] = bfhi(a.x); v[2] = bflo(a.y); v[3] = bfhi(a.y); v[4] = bflo(a.z); v[5] = bfhi(a.z); v[6] = bflo(a.w); v[7] = bfhi(a.w);
    v[8] = bflo(b.x); v[9] = bfhi(b.x); v[10] = bflo(b.y); v[11] = bfhi(b.y); v[12] = bflo(b.z); v[13] = bfhi(b.z); v[14] = bflo(b.w); v[15] = bfhi(b.w);
    float ss = 0.f;
#pragma unroll
    for (int i = 0; i < 16; ++i) ss += v[i] * v[i];
    ss += __shfl_xor(ss, 1); ss += __shfl_xor(ss, 2); ss += __shfl_xor(ss, 4); ss += __shfl_xor(ss, 8);
    const float rstd = 1.f / sqrtf(ss * (1.f / 256.f) + RMS_EPS);
    const f32x4* g4 = (const f32x4*)(gg + 16 * lane);
#pragma unroll
    for (int q = 0; q < 4; ++q) { const f32x4 g = g4[q]; v[4 * q] *= rstd * g.x; v[4 * q + 1] *= rstd * g.y; v[4 * q + 2] *= rstd * g.z; v[4 * q + 3] *= rstd * g.w; }
    v4u oa, ob;
    oa.x = pk2(v[0], v[1]); oa.y = pk2(v[2], v[3]); oa.z = pk2(v[4], v[5]); oa.w = pk2(v[6], v[7]);
    ob.x = pk2(v[8], v[9]); ob.y = pk2(v[10], v[11]); ob.z = pk2(v[12], v[13]); ob.w = pk2(v[14], v[15]);
    p[0] = oa; p[1] = ob;
}

__device__ __forceinline__ bf16x8 lds_col8(const LAS bf16* p) {
    bf16x8 r;
#pragma unroll
    for (int j = 0; j < 8; ++j) r[j] = (short)p[j * 256];
    return r;
}
__device__ __forceinline__ void f1_unit(const bf16* proj, const bf16* tab0  , const bf16* tab1  , bf16* Z, LAS unsigned char* lds, int b, int t2, int tid, int wid_s) {
    const int lane = tid & 63, wid = tid >> 6, c32 = lane & 31, hi = lane >> 5, n0 = 32 * wid;
    LAS bf16* Xs = (LAS bf16*)lds;
    {
      const int tq = otid(), lq = tq & 63, cq = lq & 31, hq = lq >> 5, hh = wid_s >> 1, ri = wid_s & 1;
      const bf16* ub = proj + ((size_t)b * SEQ + t2) * NP + C_CU + hh * 64 + 8 * hq + (size_t)cq * 128 * NP;
      bf16x8 af[4][4], bfr[2][4];
#pragma unroll
      for (int i = 0; i < 4; ++i)
#pragma unroll
          for (int s = 0; s < 4; ++s) af[i][s] = *(const bf16x8*)(ub + (size_t)(32 * i) * 128 * NP + 16 * s);
#pragma unroll
      for (int j = 0; j < 2; ++j)
#pragma unroll
          for (int s = 0; s < 4; ++s) bfr[j][s] = *(const bf16x8*)(tab0 + (size_t)(ri * 64 + 32 * j + cq) * 64 + 16 * s + 8 * hq);
#pragma unroll
      for (int i = 0; i < 4; ++i)
#pragma unroll
          for (int j = 0; j < 2; ++j) { f32x16 va = f32x16{};
#pragma unroll
              for (int s = 0; s < 4; ++s) va = __builtin_amdgcn_mfma_f32_32x32x16_bf16(af[i][s], bfr[j][s], va, 0, 0, 0);
#pragma unroll
              for (int r = 0; r < 16; r += 2) { const unsigned w2 = hwpk2(va[r], va[r + 1]); LAS bf16* xo = Xs + (ri * 128 + 32 * i + crow(r, hq)) * 256 + hh * 64 + 32 * j + cq; xo[0] = (bf16)(w2 & 0xffffu); xo[256] = (bf16)(w2 >> 16); } } }
    __syncthreads();
    f32x16 acc[8];
#pragma unroll
    for (int i = 0; i < 8; ++i) acc[i] = f32x16{};
    const bf16* ap = tab1 + (size_t)c32 * 256 + 8 * hi;
    bf16x8 an[8];
#pragma unroll
    for (int i = 0; i < 8; ++i) an[i] = *(const bf16x8*)(ap + (size_t)i * 32 * 256);
#pragma unroll 1
    for (int s = 0; s < 16; ++s) {
        bf16x8 ac[8];
#pragma unroll
        for (int i = 0; i < 8; ++i) ac[i] = an[i];
        const int sn = s < 15 ? s + 1 : s;
#pragma unroll
        for (int i = 0; i < 8; ++i) an[i] = *(const bf16x8*)(ap + (size_t)i * 32 * 256 + 16 * sn);
        const bf16x8 bfr = lds_col8(Xs + (16 * s + 8 * hi) * 256 + n0 + c32);
#pragma unroll
        for (int i = 0; i < 8; ++i) acc[i] = __builtin_amdgcn_mfma_f32_32x32x16_bf16(ac[i], bfr, acc[i], 0, 0, 0);
    }
    __syncthreads();
    LAS bf16* Zs = (LAS bf16*)lds;
#pragma unroll
    for (int i = 0; i < 4; ++i)
#pragma unroll
        for (int r = 0; r < 16; ++r) {
            const int k1 = 32 * i + crow(r, hi);
            const float rev = (float)((k1 * t2) & (SEQ - 1)) * (1.0f / SEQ);
            const float ct = hw_cos(rev), st = hw_sin(rev);
            const float zr = acc[i][r], zi = acc[i + 4][r];
            LAS bf16* zo = Zs + k1 * 512 + n0 + c32;
            { const unsigned w2 = hwpk2(zr * ct + zi * st, zi * ct - zr * st); zo[0] = (bf16)(w2 & 0xffffu); zo[256] = (bf16)(w2 >> 16); }
            __builtin_amdgcn_sched_barrier(0);
        }
    __syncthreads();
    { bf16* zb = Z + (((size_t)b * 128) * 128 + t2) * 512; const int tid = otid();
#pragma unroll
      for (int it = 0; it < 16; ++it) { const int c = it * 512 + tid, k1 = c >> 6, c16 = c & 63; *(v4u*)(zb + (size_t)k1 * 128 * 512 + c16 * 8) = *(const LAS v4u*)(Zs + k1 * 512 + c16 * 8); } }
    __syncthreads();
}
__device__ __forceinline__ void f2_unit(const bf16* Z, const bf16* tab2  , bf16* mix, fx_t* ssq, LAS unsigned char* lds, int b, int k1, int tid, int wid_s) {
    const int lane = tid & 63, wid = tid >> 6, c32 = lane & 31, hi = lane >> 5, n0 = 32 * wid;
    LAS bf16* Xs = (LAS bf16*)lds;
    { const bf16* xb = Z + (((size_t)b * 128 + k1) * 128) * 512; const int tid = otid();
      v4u tmp[16];
#pragma unroll
      for (int it = 0; it < 16; ++it) { const int c = it * 512 + tid, row = c >> 5, c16 = c & 31, ri = row >> 7, tt = row & 127; tmp[it] = *(const v4u*)(xb + (size_t)tt * 512 + ri * 256 + c16 * 8); }
#pragma unroll
      for (int it = 0; it < 16; ++it) { const int c = it * 512 + tid; *(LAS v4u*)(Xs + (c >> 5) * 256 + (c & 31) * 8) = tmp[it]; } }
    __syncthreads();
    f32x16 acc[4];
#pragma unroll
    for (int i = 0; i < 4; ++i) acc[i] = f32x16{};
    const bf16* ap = tab2 + (size_t)c32 * 256 + 8 * hi;
    bf16x8 an[4];
#pragma unroll
    for (int i = 0; i < 4; ++i) an[i] = *(const bf16x8*)(ap + (size_t)i * 32 * 256);
#pragma unroll 1
    for (int s = 0; s < 16; ++s) {
        bf16x8 ac[4];
#pragma unroll
        for (int i = 0; i < 4; ++i) ac[i] = an[i];
        const int sn = s < 15 ? s + 1 : s;
#pragma unroll
        for (int i = 0; i < 4; ++i) an[i] = *(const bf16x8*)(ap + (size_t)i * 32 * 256 + 16 * sn);
        const bf16x8 bfr = lds_col8(Xs + (16 * s + 8 * hi) * 256 + n0 + c32);
#pragma unroll
        for (int i = 0; i < 4; ++i) acc[i] = __builtin_amdgcn_mfma_f32_32x32x16_bf16(ac[i], bfr, acc[i], 0, 0, 0);
    }
    __syncthreads();
    LAS bf16* Ys = (LAS bf16*)lds;
#pragma unroll
    for (int i = 0; i < 4; ++i)
#pragma unroll
        for (int r = 0; r < 16; r += 2) { const unsigned w2 = hwpk2(acc[i][r], acc[i][r + 1]); LAS bf16* yo = Ys + (32 * i + crow(r, hi)) * 256 + n0 + c32; yo[0] = (bf16)(w2 & 0xffffu); yo[256] = (bf16)(w2 >> 16); }
    __syncthreads();
    { bf16* yb = mix + ((size_t)b * SEQ + k1) * DM + 512; const int tid = otid();
#pragma unroll
      for (int it = 0; it < 8; ++it) { const int c = it * 512 + tid, k2 = c >> 5, c16 = c & 31; const v4u v = *(const LAS v4u*)(Ys + k2 * 256 + c16 * 8); *(v4u*)(yb + (size_t)k2 * 128 * DM + c16 * 8) = v;
          float sq = (bflo(v.x) * bflo(v.x) + bfhi(v.x) * bfhi(v.x)) + (bflo(v.y) * bflo(v.y) + bfhi(v.y) * bfhi(v.y)) + (bflo(v.z) * bflo(v.z) + bfhi(v.z) * bfhi(v.z)) + (bflo(v.w) * bflo(v.w) + bfhi(v.w) * bfhi(v.w));
          sq += __shfl_xor(sq, 1); sq += __shfl_xor(sq, 2); sq += __shfl_xor(sq, 4); sq += __shfl_xor(sq, 8); sq += __shfl_xor(sq, 16);
          if (c16 == 0) ssq[4 * ((size_t)b * SEQ + k1 + 128 * k2) + 2] = fx_from(sq, FX_SQ); } }
    __syncthreads();
}

constexpr int WA_KROW = 72, WA_VROW = 392, WA_LDS_V = 384 * WA_KROW * 2;
__device__ __forceinline__ void wina_unit(const bf16* proj, const float* sink, bf16* mix, fx_t* ssq, LAS unsigned char* lds, int b, int qt, int kvh, int tid) {
    const int lane = tid & 63, wid = tid >> 6, c32 = lane & 31, hi = lane >> 5;
    const int q0 = qt * 128, kbase = q0 - 128;
    const int kbeg = kbase < 0 ? 0 : kbase, kend = (q0 + 256 > SEQ) ? SEQ : q0 + 256, nkv = kend - kbeg;
    LAS bf16* Ks = (LAS bf16*)lds; LAS bf16* Vt = (LAS bf16*)(lds + WA_LDS_V);
    const bf16* pb = proj + (size_t)b * SEQ * NP;
    { v4u kk[6], vv[6];
#pragma unroll
      for (int it = 0; it < 6; ++it) { const int idx = it * (NWAVES * 64) + tid; const int ic = idx < nkv * 8 ? idx : 0, ch = ic / nkv, row = ic - ch * nkv, kv = kbeg + row;
          kk[it] = *(const v4u*)(pb + (size_t)kv * NP + C_AK + kvh * 64 + ch * 8); vv[it] = *(const v4u*)(pb + (size_t)kv * NP + C_AV + kvh * 64 + ch * 8); }
#pragma unroll
      for (int it = 0; it < 6; ++it) { const int idx = it * (NWAVES * 64) + tid; if (idx < nkv * 8) {
          const int ch = idx / nkv, row = idx - ch * nkv, lr = kbeg + row - kbase;
          *(LAS v4u*)(Ks + lr * WA_KROW + ch * 8) = kk[it];
          LAS bf16* vp = Vt + (ch * 8) * WA_VROW + lr; const v4u v = vv[it];
          vp[0] = (bf16)(v.x & 0xffffu); vp[WA_VROW] = (bf16)(v.x >> 16); vp[2 * WA_VROW] = (bf16)(v.y & 0xffffu); vp[3 * WA_VROW] = (bf16)(v.y >> 16);
          vp[4 * WA_VROW] = (bf16)(v.z & 0xffffu); vp[5 * WA_VROW] = (bf16)(v.z >> 16); vp[6 * WA_VROW] = (bf16)(v.w & 0xffffu); vp[7 * WA_VROW] = (bf16)(v.w >> 16); } } }
    __syncthreads();
    const int g = wid >> 2, h = kvh * 2 + g, qw = q0 + 32 * (wid & 3), qpos = qw + c32;
    bf16x8 qf[4];
    { const bf16* qp = pb + (size_t)qpos * NP + C_AQ + h * 64 + 8 * hi;
#pragma unroll
      for (int d0 = 0; d0 < 4; ++d0) qf[d0] = *(const bf16x8*)(qp + 16 * d0); }
    const float slope2 = __builtin_amdgcn_exp2f(-2.0f * (float)(h + 1)) * LOG2E, sc2 = 0.125f * LOG2E, sink2 = sink[h] * LOG2E;
    float m = sink2, l = 0.f;
    f32x16 ot[2]; ot[0] = f32x16{}; ot[1] = f32x16{};
    const int t_lo = (qw - 128 < 0) ? 0 : qw - 128, t_hi = (qw + 160 > SEQ) ? SEQ : qw + 160;
    for (int kv0 = t_lo; kv0 < t_hi; kv0 += 32) {
        const int lr = kv0 - kbase;
        f32x16 sacc = f32x16{};
#pragma unroll
        for (int d0 = 0; d0 < 4; ++d0) { const bf16x8 kf = *(const LAS bf16x8*)(Ks + (lr + c32) * WA_KROW + 16 * d0 + 8 * hi); sacc = __builtin_amdgcn_mfma_f32_32x32x16_bf16(kf, qf[d0], sacc, 0, 0, 0); }
        float x[16]; float mx = -1e30f;
#pragma unroll
        for (int r = 0; r < 16; ++r) { const int kv = kv0 + crow(r, hi); int dist = qpos - kv; dist = dist < 0 ? -dist : dist;
            x[r] = (dist <= 128) ? (sacc[r] * sc2 - slope2 * (float)dist) : -1e30f; mx = fmaxf(mx, x[r]); }
        mx = fmaxf(mx, __shfl_xor(mx, 32));
        const float mnew = fmaxf(m, mx), alpha = __builtin_amdgcn_exp2f(m - mnew); const bool grow = __any(mnew > m); m = mnew;
        float ps = 0.f;
#pragma unroll
        for (int r = 0; r < 16; ++r) { x[r] = __builtin_amdgcn_exp2f(x[r] - m); ps += x[r]; }
        l = l * alpha + ps;
        if (grow) {
#pragma unroll
            for (int r = 0; r < 16; ++r) { ot[0][r] *= alpha; ot[1][r] *= alpha; } }
        v4u pw0, pw1;
        pw0.x = hwpk2(x[0], x[1]); pw0.y = hwpk2(x[2], x[3]); pw0.z = hwpk2(x[4], x[5]); pw0.w = hwpk2(x[6], x[7]);
        pw1.x = hwpk2(x[8], x[9]); pw1.y = hwpk2(x[10], x[11]); pw1.z = hwpk2(x[12], x[13]); pw1.w = hwpk2(x[14], x[15]);
        const bf16x8 pa0 = __builtin_bit_cast(bf16x8, pw0), pa1 = __builtin_bit_cast(bf16x8, pw1);
#pragma unroll
        for (int dt = 0; dt < 2; ++dt) {
            const LAS bf16* vb = Vt + (32 * dt + c32) * WA_VROW + lr + 4 * hi;
            const s16x4 a0 = *(const LAS s16x4*)(vb), a1 = *(const LAS s16x4*)(vb + 8), b0 = *(const LAS s16x4*)(vb + 16), b1 = *(const LAS s16x4*)(vb + 24);
            const bf16x8 v0 = (bf16x8){a0[0], a0[1], a0[2], a0[3], a1[0], a1[1], a1[2], a1[3]}, v1 = (bf16x8){b0[0], b0[1], b0[2], b0[3], b1[0], b1[1], b1[2], b1[3]};
            ot[dt] = __builtin_amdgcn_mfma_f32_32x32x16_bf16(v0, pa0, ot[dt], 0, 0, 0);
            ot[dt] = __builtin_amdgcn_mfma_f32_32x32x16_bf16(v1, pa1, ot[dt], 0, 0, 0);
        }
    }
    l += __shfl_xor(l, 32); l += __builtin_amdgcn_exp2f(sink2 - m);
    const float inv = 1.0f / l;
    bf16* op = mix + ((size_t)b * SEQ + qpos) * DM + h * 64 + 4 * hi; float sq = 0.f;
#pragma unroll
    for (int dt = 0; dt < 2; ++dt)
#pragma unroll
        for (int rg = 0; rg < 4; ++rg) { v2u o; o.x = hwpk2(ot[dt][4 * rg] * inv, ot[dt][4 * rg + 1] * inv); o.y = hwpk2(ot[dt][4 * rg + 2] * inv, ot[dt][4 * rg + 3] * inv);
            *(v2u*)(op + 32 * dt + 8 * rg) = o; sq += (bflo(o.x) * bflo(o.x) + bfhi(o.x) * bfhi(o.x)) + (bflo(o.y) * bflo(o.y) + bfhi(o.y) * bfhi(o.y)); }
    sq += __shfl_xor(sq, 32);
    if (hi == 0) fx_atomic_add(ssq + 4 * ((size_t)b * SEQ + qpos), fx_from(sq, FX_SQ));
    __syncthreads();
}

typedef const __attribute__((address_space(4))) Args* kargs_t;
__device__ __forceinline__ kargs_t kargs() { kargs_t p = (kargs_t)__builtin_amdgcn_kernarg_segment_ptr(); asm volatile("" : "+s"(p)); return p; }
#define KA (kargs())
#define WSB ((unsigned char*)KA->ws)
#define TAB1 ((bf16*)(WSB + WS_TAB1))
#define TAB2 ((bf16*)(WSB + WS_TAB2))
#define TAB0 ((bf16*)(WSB + WS_TAB0))
#define HB ((bf16*)(WSB + WS_HB))
#define PROJ ((bf16*)(WSB + WS_PROJ))
#define KD ((bf16*)(WSB + WS_KD))
#define ZB ((bf16*)(WSB + WS_Z))
#define MIX ((bf16*)(WSB + WS_MIX))
#define ACT ((bf16*)(WSB + WS_ACT))
#define CS ((fx_t*)(WSB + WS_CS))
#define CSF ((float*)(WSB + WS_CSF))
#define ST ((fx_t*)(WSB + WS_ST))
__global__ void __launch_bounds__(NWAVES * 64, 2) hymba_fwd(Args a) {
    extern __shared__ __attribute__((aligned(16))) unsigned char lds_raw[];
    cg::grid_group grid = cg::this_grid();
    LAS unsigned char* lds = (LAS unsigned char*)lds_raw;
    const int wid_s = __builtin_amdgcn_readfirstlane((int)threadIdx.x >> 6);
    const int tid = otid(), lane = tid & 63, wid = wid_s;
    const int G = gridDim.x, bx = blockIdx.x;
    const int vcu = (G % 8 == 0) ? (bx % 8) * (G / 8) + bx / 8 : bx;
    const int gw = vcu * NWAVES + wid, NGW = G * NWAVES;
    volatile LAS unsigned* MISC = (volatile LAS unsigned*)(lds + RING_BYTES + 320);
    if (tid < 32) MISC[tid] = 0u;
    __syncthreads();
    (void)xcd_barrier_post((unsigned*)WSB, MISC + 8);
#define GSYNC() do { XcdBarrier b_; b_.bar = (unsigned*)WSB; b_.x = xb_xcc_id(); b_.st = (volatile LAS unsigned*)(lds + RING_BYTES + 320) + 8; xcd_barrier(b_); } while (0)
    if (KA->ws == nullptr) grid.sync();

    {
        LAS float* scr = (LAS float*)(lds + wid * 16384);
        constexpr int I_IN = 16 * 64, I_FO = 0, I_OUT = 16 * 32, I_1 = 16 * 128, I_2 = 64 * 32, I_L = I_IN + I_FO + I_OUT + I_1 + I_2;
        for (int it = gw; it < DEPTH * I_L; it += NGW) {
            const int L = it / I_L; int r = it % I_L;
            unsigned char* wl = WSB + WS_W + (size_t)L * W_LAYER; fx_t* csl = CS + (size_t)L * CS_LAYER;
            const float* gin = L ? KA->ln2_g + (L - 1) * DM : KA->ln_in_g; const float* bin = L ? KA->ln2_b + (L - 1) * DM : KA->ln_in_b;
            if (r < I_IN) { const int kb = r / 64, nb = r % 64, n0 = 32 * nb;
                transpose_item(KA->w_in + (size_t)L * 1024 * 2048, 1024, 2048, (bf16*)(wl + W_IN), 64 * kb, n0, n0, scr, lane, gin, bin, csl, csl + 2304); continue; } r -= I_IN;
            r -= 0;
            if (r < I_OUT) { transpose_item(KA->w_out + (size_t)L * 1024 * 1024, 1024, 1024, (bf16*)(wl + W_OUT), 64 * (r / 32), 32 * (r % 32), 32 * (r % 32), scr, lane, KA->grp_g + L * DM); continue; } r -= I_OUT;
            if (r < I_1) { transpose_item(KA->w1 + (size_t)L * 1024 * 4096, 1024, 4096, (bf16*)(wl + W_1), 64 * (r / 128), 32 * (r % 128), 32 * (r % 128), scr, lane, KA->ln1_g + L * DM, KA->ln1_b + L * DM, csl + 4608, csl + 4608 + 4096); continue; } r -= I_1;
            transpose_item(KA->w2 + (size_t)L * 4096 * 1024, 4096, 1024, (bf16*)(wl + W_2), 64 * (r / 32), 32 * (r % 32), 32 * (r % 32), scr, lane);
        }
        const int gt = vcu * NWAVES * 64 + tid, NGT = G * NWAVES * 64;
        const float rs = 0.08838834764831845f;
        for (int e = gt; e < 256 * 256; e += NGT) { const int m = e >> 8, k = e & 255, ro = m >> 7, k1 = m & 127, ri = k >> 7, t1 = k & 127;
            const float rev = (float)((k1 * t1) & 127) * (1.0f / 128.0f); const float c = hw_cos(rev) * rs, s = hw_sin(rev) * rs;
            TAB1[e] = (bf16)f2bf(ro == ri ? c : (ro == 0 ? s : -s)); }
        for (int e = gt; e < 128 * 256; e += NGT) { const int k2 = e >> 8, k = e & 255, ri = k >> 7, tt = k & 127;
            const float rev = (float)((k2 * tt) & 127) * (1.0f / 128.0f);
            TAB2[e] = (bf16)f2bf((ri == 0 ? hw_cos(rev) : hw_sin(rev)) * rs); }
        for (int e = gt; e < 128 * 64; e += NGT) { const int n = e >> 6, c = e & 63, ri = n >> 6, cp = n & 63;
            const float rev = (float)((c * cp) & 63) * (1.0f / 64.0f);
            TAB0[e] = (bf16)f2bf((ri == 0 ? hw_cos(rev) : -hw_sin(rev)) * 0.125f); }
#pragma unroll 4
        for (int m = gw; m < T; m += NGW) row_to_y(KA->x + (size_t)m * DM, HB + (size_t)m * DM, ST + (size_t)m, lane);
    }
    GSYNC();

    for (int L = 0; L < DEPTH; ++L) {
#define wl (WSB + WS_W + (size_t)L * W_LAYER)
#define csl (CS + (size_t)L * CS_LAYER)
#define csf (CSF + (size_t)L * CS_LAYER)
#define gin (L ? KA->ln2_g + (L - 1) * DM : KA->ln_in_g)
#define bin (L ? KA->ln2_b + (L - 1) * DM : KA->ln_in_b)
#define SSQ ((fx_t*)(WSB + WS_SSQ) + (size_t)L * (4 * T))
#define st0 (ST + (size_t)(2 * L) * T)
#define st1 (ST + (size_t)(2 * L + 1) * T)
#define st2 (ST + (size_t)(2 * L + 2) * T)
        { pg8::Gemm g{HB, (const bf16*)(wl + W_IN), T, NP, DM}; pg8::StaticOrder S; S.init(T, NP, G, obx());
          if (L == 0) { pg8::EpiLnBf16<0, true> E{PROJ, NP, st0, csl, csl + 2304, LN_EPS, lds + RING_BYTES + 1024};
              pg8::gemm_phase<pg8::EpiLnBf16<0, true>, pg8::StaticOrder, true, true>(lds, g, S, E, otid()); }
          else { pg8::EpiLnBf16<0> E{PROJ, NP, st0, csf, csf + 2304, LN_EPS, lds + RING_BYTES + 1024};
              pg8::gemm_phase<pg8::EpiLnBf16<0>, pg8::StaticOrder, true, true>(lds, g, S, E, otid()); } }
        GSYNC();
        if (L == 0) { const int pt = otid(); for (int e = vcu * NWAVES * 64 + pt; e < DEPTH * (int)CS_LAYER; e += G * NWAVES * 64) CSF[e] = fx_to(CS[e], FX_CS); }
        { const int pt = otid(), pl = pt & 63, pw = vcu * NWAVES + (pt >> 6); for (int t = pw; t < T; t += 8 * NGW) prep_k_tokens<8>(PROJ, KA->kn_g + L * 64, KD, t, NGW, pl); }
        { const int pt = otid(), pl = pt & 63, pw = vcu * NWAVES + (pt >> 6); for (int t = pw; t < T; t += 8 * NGW) conv_tokens<8>(PROJ, KA->conv_w + L * 768, MIX, SSQ, t, NGW, pl); }
        { const int pt = otid(); for (int u = ovcu(); u < BATCH * 128; u += G) f1_unit(PROJ, TAB0, TAB1, ZB, lds, u >> 7, u & 127, pt, wid_s); }
        { const int pt = otid(); for (int u = ovcu(); u < BATCH * 128 * 2; u += G) wina_unit(PROJ, KA->sink + L * 4, MIX, SSQ, lds, u >> 8, (u >> 1) & 127, u & 1, pt); }
        GSYNC();
        {
          for (int uid = ovcu(); uid < 256; uid += G) { const int bk = uid >> 6, r = uid & 63, b = bk >> 1, h = (bk & 1) * 2 + (r >> 5), qb = r & 31;
              attn_body::attn_unit64(b, h, qb, (const attn_body::bf16*)(PROJ + C_DQ), (const attn_body::bf16*)KD, (const attn_body::bf16*)(PROJ + C_DV), (attn_body::bf16*)(MIX + 768), (char*)lds_raw, KA->qn_g + L * 64, KA->kn_g + L * 64, SSQ + 3, wid_s); } }
        { const int pt = otid(); for (int u = ovcu(); u < BATCH * 128; u += G) f2_unit(ZB, TAB2, MIX, SSQ, lds, u >> 7, u & 127, pt, wid_s); }
        GSYNC();
        { pg8::Gemm g{MIX, (const bf16*)(wl + W_OUT), T, DM, DM}; pg8::StaticOrder S; S.init(T, DM, G, obx());
          pg8::EpiResLn E{HB, DM, st0, st1, gin, bin, DN_ALPHA, LN_EPS}; pg8::GroupScale R{SSQ, RMS_EPS, (LAS float*)(lds + RING_BYTES + 1024)};
          { const int pt = otid(); pg8::Unit u0; for (int i = 0; i < 2; ++i) if (S.next(i, u0)) R.prepare(u0, i, pt); }
          __syncthreads();
          pg8::gemm_phase<pg8::EpiResLn, pg8::StaticOrder, true, true, pg8::GroupScale>(lds, g, S, E, otid(), R); }
        GSYNC();
        { pg8::Gemm g{HB, (const bf16*)(wl + W_1), T, FF, DM}; pg8::StaticOrder S; S.init(T, FF, G, obx());
          pg8::EpiLnBf16<2> E{ACT, FF, st1, csf + 4608, csf + 4608 + 4096, LN_EPS, lds + RING_BYTES + 1024};
          pg8::gemm_phase<pg8::EpiLnBf16<2>, pg8::StaticOrder, true, true>(lds, g, S, E, otid()); }
        GSYNC();
        { pg8::Gemm g{ACT, (const bf16*)(wl + W_2), T, DM, FF}; pg8::StaticOrder S; S.init(T, DM, G, obx());
          pg8::EpiResLn E{HB, DM, st1, st2, KA->ln1_g + L * DM, KA->ln1_b + L * DM, DN_ALPHA, LN_EPS};
          pg8::gemm_phase<pg8::EpiResLn, pg8::StaticOrder, true, true>(lds, g, S, E, otid()); }
        GSYNC();
    }
    { const int pt = otid(), pl = pt & 63, pw = vcu * NWAVES + (pt >> 6); const fx_t* stf = ST + (size_t)(2 * DEPTH) * T;
#pragma unroll 4
      for (int m = pw; m < T; m += NGW) y_to_out(HB + (size_t)m * DM, stf + (size_t)m, KA->ln2_g + (DEPTH - 1) * DM, KA->ln2_b + (DEPTH - 1) * DM, KA->out + (size_t)m * DM, pl); }
}
#undef wl
#undef csl
#undef gin
#undef bin
#undef SSQ
#undef st0
#undef st1
#undef st2
}

extern "C" void kernel_launch(void* const* d_in, const int* in_sizes, int n_in, void* d_out, int out_size, void* d_ws, size_t ws_size, hipStream_t stream) {
    static int grid = 0;
    if (grid == 0) {
        if (n_in != 16 || out_size != mk::T * mk::DM || ws_size < mk::WS_END) { fprintf(stderr, "kernel_launch: unexpected shapes (n_in %d, out %d, ws %zu)\n", n_in, out_size, ws_size); grid = -1; return; }
        int dev = 0, cus = 0, per_cu = 0;
        (void)hipGetDevice(&dev); (void)hipDeviceGetAttribute(&cus, hipDeviceAttributeMultiprocessorCount, dev);
        if (hipFuncSetAttribute((const void*)mk::hymba_fwd, hipFuncAttributeMaxDynamicSharedMemorySize, mk::LDS_BYTES) != hipSuccess) { fprintf(stderr, "kernel_launch: hipFuncSetAttribute failed\n"); grid = -1; return; }
        if (hipOccupancyMaxActiveBlocksPerMultiprocessor(&per_cu, (const void*)mk::hymba_fwd, mk::NWAVES * 64, mk::LDS_BYTES) != hipSuccess || per_cu < 1) { fprintf(stderr, "kernel_launch: occupancy query says %d\n", per_cu); per_cu = 1; }
        (void)hipGetLastError();
        grid = cus * 1;
        if (grid * 2 < 512) { fprintf(stderr, "kernel_launch: this build needs >= 256 workgroups (got %d)\n", grid); grid = -1; return; }
    }
    if (grid < 0) return;
    if (hipMemsetAsync(d_ws, 0, mk::WS_ZERO_BYTES, stream) != hipSuccess) { fprintf(stderr, "kernel_launch: memset of the barrier words failed\n"); return; }
    if (hipMemsetAsync((char*)d_ws + mk::WS_SSQ, 0, mk::WS_ZERO2_BYTES, stream) != hipSuccess) { fprintf(stderr, "kernel_launch: memset of the group sums failed\n"); return; }
    mk::Args a{};
    const float** pp = (const float**)&a;
    for (int i = 0; i < 16; ++i) pp[i] = (const float*)d_in[i];
    a.out = (float*)d_out; a.ws = (unsigned char*)d_ws;
    void* args[] = {&a};
    hipError_t e = hipLaunchCooperativeKernel((const void*)mk::hymba_fwd, dim3(grid), dim3(mk::NWAVES * 64), args, mk::LDS_BYTES, stream);
    if (e != hipSuccess) fprintf(stderr, "cooperative launch failed: %s (grid %d)\n", hipGetErrorString(e), grid);
}
```

```cpp
#include <hip/hip_runtime.h>
#include <hip/hip_cooperative_groups.h>
#include <cstdio>
#include <cstdint>
#include <hip/hip_bf16.h>
#include <cmath>
namespace cg = cooperative_groups;
__device__ __forceinline__ int mk_lane() { int t; asm volatile("v_mbcnt_lo_u32_b32 %0, -1, 0\n\tv_mbcnt_hi_u32_b32 %0, -1, %0" : "=&v"(t)); return t; }
__device__ __forceinline__ float mk_shfl_xor_l(float v, int m, int lane) { return __builtin_bit_cast(float, __builtin_amdgcn_ds_bpermute((lane ^ m) << 2, __builtin_bit_cast(int, v))); }
#define __shfl_xor(v, m) mk_shfl_xor_l((v), (m), mk_lane())
typedef long long fx_t;
constexpr double FX_ST = 1073741824.0, FX_SQ = 68719476736.0, FX_CS = 1099511627776.0;
__device__ __forceinline__ fx_t fx_from(float v, double sc) { return (fx_t)__builtin_rint((double)v * sc); }
__device__ __forceinline__ float fx_to(fx_t v, double sc) { const int hi = (int)(v >> 32); const unsigned lo = (unsigned)v;
    return (float)hi * (float)(4294967296.0 / sc) + (float)lo * (float)(1.0 / sc); }
__device__ __forceinline__ void fx_atomic_add(fx_t* p, fx_t v) { (void)__hip_atomic_fetch_add((unsigned long long*)p, (unsigned long long)v, __ATOMIC_RELAXED, __HIP_MEMORY_SCOPE_AGENT); }
__device__ __forceinline__ fx_t st_pack(float s, float q) { return (fx_t)(((unsigned long long)(unsigned)(int)__builtin_rintf(s * 131072.0f) << 32) + (unsigned long long)(unsigned)__builtin_rintf(q * 16384.0f)); }
__device__ __forceinline__ void st_unpack(fx_t v, float& s, float& q) { s = (float)(int)(v >> 32) * (1.0f / 131072.0f); q = (float)(unsigned)v * (1.0f / 16384.0f); }
namespace pg8 {
#define PG8_LAS __attribute__((address_space(3)))
typedef unsigned short bf16_t;
typedef short bf16x8 __attribute__((ext_vector_type(8)));
typedef float f32x4 __attribute__((ext_vector_type(4)));
typedef unsigned u32x4 __attribute__((ext_vector_type(4)));
constexpr int BM = 256, BK = 64, HALF = 128, HTB = HALF * BK * 2  , STAGE_BYTES = 8 * HTB, NXCD = 8, WGM = 4;

__host__ __device__ __forceinline__ int lds_byte(int r, int c) { const int st = (r >> 4) * 2 + (c >> 5), rr = r & 15, cc = c & 31, ob = rr * 64 + cc * 2; return st * 1024 + (ob ^ (((ob >> 9) & 1) << 5)); }
__host__ __device__ __forceinline__ void stage_rc(int b, int& R, int& C) { const int st = b / 1024, sb = b % 1024, swz = sb ^ (((sb >> 9) & 1) << 5); R = (st >> 1) * 16 + swz / 64; C = (st & 1) * 32 + (swz % 64) / 2; }
__host__ __device__ __forceinline__ int perm32(int rho) { const int n = rho >> 4, i = rho & 15; return 8 * (i >> 2) + 4 * n + (i & 3); }

struct Unit { int pm, pn; };
struct Gemm { const bf16_t* A; const bf16_t* Bt; int M, N, K; };

struct StaticOrder {
    int nM, nN, nwg, G, c;
    __host__ __device__ void init(int M, int N, int G_, int c_) { nM = M / BM; nN = N / BM; nwg = nM * nN; G = G_; c = c_; }
    __host__ __device__ bool next(int i, Unit& u) const {
        const long L = (long)i * G + c; if (L >= nwg) return false;
        int wgid = (int)L; { const int q = nwg / NXCD, r = nwg % NXCD, xcd = wgid % NXCD, off = wgid / NXCD; wgid = (xcd < r ? xcd * (q + 1) : r * (q + 1) + (xcd - r) * q) + off; }
        const int nig = WGM * nN, gid = wgid / nig, fm = gid * WGM, gsz = (nM - fm) < WGM ? (nM - fm) : WGM;
        u.pm = fm + ((wgid % nig) % gsz); u.pn = (wgid % nig) / gsz; return true;
    }
    __device__ __forceinline__ void a_ready(const Unit&) const {}
    __device__ __forceinline__ void done(const Unit&) const {}
};

__device__ __forceinline__ unsigned cvt_pk_bf16(float lo, float hi) { unsigned r; asm volatile("v_cvt_pk_bf16_f32 %0, %1, %2" : "=v"(r) : "v"(lo), "v"(hi)); return r; }
typedef float f32x2 __attribute__((ext_vector_type(2)));
__device__ __forceinline__ f32x2 gelu_pk(f32x2 v) {
    const f32x2 av = __builtin_elementwise_abs(v), d = av * 0.2316418882f + 1.0f;
    f32x2 t; t.x = __builtin_amdgcn_rcpf(d.x); t.y = __builtin_amdgcn_rcpf(d.y);
    f32x2 q = t * 0.5307027145f + (-0.7265760135f); q = q * t + 0.7107068705f; q = q * t + (-0.142248368f); q = q * t + 0.127414796f; q = q * t;
    const f32x2 s = (v * v) * (-0.72134752044f);
    f32x2 e; e.x = __builtin_amdgcn_exp2f(s.x); e.y = __builtin_amdgcn_exp2f(s.y);
    const f32x2 m = v * (q * e), r = v - m;
    f32x2 o; o.x = v.x < 0.f ? m.x : r.x; o.y = v.y < 0.f ? m.y : r.y; return o;
}

template <int ACT  > struct EpiBf16 {
    static constexpr bool PREFETCH = false;
    static constexpr bool PERM = true, AFTER_DRAIN = false; static_assert(ACT == 0 || ACT == 1 || ACT == 2, "EpiBf16: ACT is 0 (none), 1 (gelu_pk) or 2 (relu^2)");
    bf16_t* O; int ldc; const float* bias; int split_cols; size_t split_stride; float scale0;
    __device__ __forceinline__ void operator()(const f32x4 (&acc)[2][2][4][2], const Unit& u, int wr, int wc, int fr, int fq) const {
        const int row0 = u.pm * BM + wr * 64 + fr; int colt = u.pn * BM; bf16_t* base = O;
        float sc = 1.f; if (split_cols) { const int t = colt / split_cols; base += (size_t)t * split_stride; colt -= t * split_cols; if (t == 0) sc = scale0; }
        const int col0 = colt + wc * 32 + 8 * fq, bcol0 = u.pn * BM + wc * 32 + 8 * fq;
        f32x4 bv[2][2];
#pragma unroll
        for (int bj = 0; bj < 2; ++bj)
#pragma unroll
            for (int n = 0; n < 2; ++n) bv[bj][n] = bias ? *(const f32x4*)(bias + bcol0 + bj * HALF + 4 * n) : (f32x4){0.f, 0.f, 0.f, 0.f};
#pragma unroll
        for (int ai = 0; ai < 2; ++ai)
#pragma unroll
            for (int m = 0; m < 4; ++m) { bf16_t* rowp = base + (size_t)(row0 + ai * HALF + m * 16) * ldc + col0;
#pragma unroll
                for (int bj = 0; bj < 2; ++bj) { f32x4 v0 = acc[ai][bj][m][0] + bv[bj][0], v1 = acc[ai][bj][m][1] + bv[bj][1];
                    if (ACT == 1) { f32x2 a = gelu_pk((f32x2){v0[0], v0[1]}), b = gelu_pk((f32x2){v0[2], v0[3]}), c = gelu_pk((f32x2){v1[0], v1[1]}), d = gelu_pk((f32x2){v1[2], v1[3]});
                        v0 = (f32x4){a.x, a.y, b.x, b.y}; v1 = (f32x4){c.x, c.y, d.x, d.y}; }
                    if (ACT == 2) { v0 = __builtin_elementwise_max(v0, (f32x4){0.f, 0.f, 0.f, 0.f}); v1 = __builtin_elementwise_max(v1, (f32x4){0.f, 0.f, 0.f, 0.f}); v0 = v0 * v0; v1 = v1 * v1; }
                    v0 = v0 * sc; v1 = v1 * sc; u32x4 w; w.x = cvt_pk_bf16(v0[0], v0[1]); w.y = cvt_pk_bf16(v0[2], v0[3]); w.z = cvt_pk_bf16(v1[0], v1[1]); w.w = cvt_pk_bf16(v1[2], v1[3]);
                    *(u32x4*)(rowp + bj * HALF) = w; } }
    }
};

struct EpiResF32 {
    static constexpr bool PERM = false, AFTER_DRAIN = false, PREFETCH = false;
    float* H; int ldc; float alpha;
    __device__ __forceinline__ void operator()(const f32x4 (&acc)[2][2][4][2], const Unit& u, int wr, int wc, int fr, int fq) const {
        const int col0 = u.pn * BM + wc * 32 + 4 * fq;
#pragma unroll
        for (int ai = 0; ai < 2; ++ai)
#pragma unroll
            for (int m = 0; m < 4; ++m) { const int r = ai * HALF + wr * 64 + m * 16 + fr; float* rowp = H + (size_t)(u.pm * BM + r) * ldc + col0;
#pragma unroll
                for (int bj = 0; bj < 2; ++bj)
#pragma unroll
                    for (int n = 0; n < 2; ++n) { f32x4* p = (f32x4*)(rowp + bj * HALF + n * 16); const f32x4 b = *p; *p = b * alpha + acc[ai][bj][m][n]; }
                asm volatile("" ::: "memory"); }
    }
};

template <int ACT  , bool FXCS = false  > struct EpiLnBf16 {
    static constexpr bool PERM = true, AFTER_DRAIN = false;
    bf16_t* O; int ldc; const fx_t* st; const void* cs; const void* bw; float eps; PG8_LAS unsigned char* tab;
    static constexpr bool PREFETCH = !FXCS;
    __device__ __forceinline__ void prefetch(const Unit& u, int par, int wid, int lane) const {
        PG8_LAS unsigned char* t = tab + par * 4096;
        if (wid < 2) __builtin_amdgcn_global_load_lds((const unsigned*)(st + (size_t)u.pm * BM + wid * 128) + lane * 4, (PG8_LAS unsigned*)(t + wid * 1024), 16, 0, 0);
        else if (wid == 2) __builtin_amdgcn_global_load_lds((const unsigned*)((const float*)cs + u.pn * BM) + lane * 4, (PG8_LAS unsigned*)(t + 2048), 16, 0, 0);
        else if (wid == 3) __builtin_amdgcn_global_load_lds((const unsigned*)((const float*)bw + u.pn * BM) + lane * 4, (PG8_LAS unsigned*)(t + 3072), 16, 0, 0);
    }
    __device__ __forceinline__ void operator()(const f32x4 (&acc)[2][2][4][2], const Unit& u, int wr, int wc, int fr, int fq, int par = 0) const {
        const int row0 = u.pm * BM + wr * 64 + fr, col0 = u.pn * BM + wc * 32 + 8 * fq;
        f32x4 cv[2][2], bv[2][2];
#pragma unroll
        for (int bj = 0; bj < 2; ++bj)
#pragma unroll
            for (int n = 0; n < 2; ++n) { const int cc = col0 + bj * HALF + 4 * n;
                if constexpr (FXCS) { const fx_t* cp = (const fx_t*)cs + cc; const fx_t* bp = (const fx_t*)bw + cc;
                    cv[bj][n] = (f32x4){fx_to(cp[0], FX_CS), fx_to(cp[1], FX_CS), fx_to(cp[2], FX_CS), fx_to(cp[3], FX_CS)}; bv[bj][n] = (f32x4){fx_to(bp[0], FX_CS), fx_to(bp[1], FX_CS), fx_to(bp[2], FX_CS), fx_to(bp[3], FX_CS)}; }
                else { const int lc = wc * 32 + 8 * fq + bj * HALF + 4 * n; cv[bj][n] = *(const PG8_LAS f32x4*)(tab + par * 4096 + 2048 + lc * 4); bv[bj][n] = *(const PG8_LAS f32x4*)(tab + par * 4096 + 3072 + lc * 4); } }
#pragma unroll
        for (int ai = 0; ai < 2; ++ai)
#pragma unroll
            for (int m = 0; m < 4; ++m) { const int row = row0 + ai * HALF + m * 16; f32x2 sv; { float s_, q_; const fx_t sw = FXCS ? st[row] : *(const PG8_LAS fx_t*)(tab + par * 4096 + (ai * HALF + wr * 64 + m * 16 + fr) * 8); st_unpack(sw, s_, q_); sv = (f32x2){s_, q_}; }
                const float mean = sv.x * (1.0f / 1024.0f), rstd = __builtin_amdgcn_rsqf(sv.y * (1.0f / 1024.0f) - mean * mean + eps), mr = -mean * rstd;
                bf16_t* rowp = O + (size_t)row * ldc + col0;
#pragma unroll
                for (int bj = 0; bj < 2; ++bj) { f32x4 v0 = acc[ai][bj][m][0] * rstd + (cv[bj][0] * mr + bv[bj][0]), v1 = acc[ai][bj][m][1] * rstd + (cv[bj][1] * mr + bv[bj][1]);
                    if (ACT == 2) { v0 = __builtin_elementwise_max(v0, (f32x4){0.f, 0.f, 0.f, 0.f}); v1 = __builtin_elementwise_max(v1, (f32x4){0.f, 0.f, 0.f, 0.f}); v0 = v0 * v0; v1 = v1 * v1; }
                    u32x4 w; w.x = cvt_pk_bf16(v0[0], v0[1]); w.y = cvt_pk_bf16(v0[2], v0[3]); w.z = cvt_pk_bf16(v1[0], v1[1]); w.w = cvt_pk_bf16(v1[2], v1[3]);
                    *(u32x4*)(rowp + bj * HALF) = w; } }
    }
};
struct EpiResLn {
    static constexpr bool PERM = false, AFTER_DRAIN = false, PREFETCH = false;
    bf16_t* Y; int ldc; const fx_t* st_in; fx_t* st_out; const float* g; const float* b; float alpha, eps;
    __device__ __forceinline__ void operator()(const f32x4 (&acc)[2][2][4][2], const Unit& u, int wr, int wc, int fr, int fq) const {
        typedef unsigned u32x2 __attribute__((ext_vector_type(2)));
        const int col0 = u.pn * BM + wc * 32 + 4 * fq;
        f32x4 gv[2][2], bv[2][2];
#pragma unroll
        for (int bj = 0; bj < 2; ++bj)
#pragma unroll
            for (int n = 0; n < 2; ++n) { gv[bj][n] = *(const f32x4*)(g + col0 + bj * HALF + n * 16); bv[bj][n] = *(const f32x4*)(b + col0 + bj * HALF + n * 16); }
#pragma unroll
        for (int ai = 0; ai < 2; ++ai) {
            u32x2 yv[4][2][2]; fx_t sw[4];
#pragma unroll
            for (int m = 0; m < 4; ++m) { const int row = u.pm * BM + ai * HALF + wr * 64 + m * 16 + fr; sw[m] = st_in[row];
                const bf16_t* rowp = Y + (size_t)row * ldc + col0;
#pragma unroll
                for (int bj = 0; bj < 2; ++bj)
#pragma unroll
                    for (int n = 0; n < 2; ++n) yv[m][bj][n] = *(const u32x2*)(rowp + bj * HALF + n * 16); }
#pragma unroll
            for (int m = 0; m < 4; ++m) { const int row = u.pm * BM + ai * HALF + wr * 64 + m * 16 + fr; float s_, q_; st_unpack(sw[m], s_, q_);
                const float mean = s_ * (1.0f / 1024.0f), rstd = __builtin_amdgcn_rsqf(q_ * (1.0f / 1024.0f) - mean * mean + eps);
                bf16_t* rowp = Y + (size_t)row * ldc + col0; float s = 0.f, q = 0.f;
#pragma unroll
                for (int bj = 0; bj < 2; ++bj)
#pragma unroll
                    for (int n = 0; n < 2; ++n) { u32x2* p = (u32x2*)(rowp + bj * HALF + n * 16); const u32x2 yw = yv[m][bj][n];
                        f32x4 y = (f32x4){__builtin_bit_cast(float, yw.x << 16), __builtin_bit_cast(float, yw.x & 0xffff0000u), __builtin_bit_cast(float, yw.y << 16), __builtin_bit_cast(float, yw.y & 0xffff0000u)};
                        const f32x4 h = (y - mean) * rstd * gv[bj][n] + bv[bj][n]; const f32x4 yn = h * alpha + acc[ai][bj][m][n];
                        u32x2 w; w.x = cvt_pk_bf16(yn[0], yn[1]); w.y = cvt_pk_bf16(yn[2], yn[3]); *p = w;
                        const float r0 = __builtin_bit_cast(float, w.x << 16), r1 = __builtin_bit_cast(float, w.x & 0xffff0000u), r2 = __builtin_bit_cast(float, w.y << 16), r3 = __builtin_bit_cast(float, w.y & 0xffff0000u);
                        s += (r0 + r1) + (r2 + r3); q += (r0 * r0 + r1 * r1) + (r2 * r2 + r3 * r3); }
                s += __shfl_xor(s, 16); s += __shfl_xor(s, 32); q += __shfl_xor(q, 16); q += __shfl_xor(q, 32);
                if (fq == 0) fx_atomic_add(st_out + row, st_pack(s, q)); }
            asm volatile("" ::: "memory");
        }
    }
};

struct NoScale { static constexpr bool ON = false; };
struct GroupScale { static constexpr bool ON = true; const fx_t* ssq;   float eps; PG8_LAS float* rtab;
    __device__ __forceinline__ void prepare(const Unit& u, int par, int tid) const {
        if (__builtin_amdgcn_readfirstlane(tid >> 6) < 4) {   const fx_t* qp = ssq + 4 * (size_t)(u.pm * BM + tid); const f32x4 q = (f32x4){fx_to(qp[0], FX_SQ), fx_to(qp[1], FX_SQ), fx_to(qp[2], FX_SQ), fx_to(qp[3], FX_SQ)};
            const float a0 = q[0] * (1.0f / 256.0f) + eps, a1 = q[1] * (1.0f / 256.0f) + eps, a2 = q[2] * (1.0f / 256.0f) + eps, a3 = q[3] * (1.0f / 256.0f) + eps;
            *(PG8_LAS f32x4*)(rtab + par * 1024 + tid * 4) = (f32x4){sqrtf(a1 / a0), sqrtf(a2 / a1), sqrtf(a3 / a2), 1.0f / sqrtf(a3)}; }
    }
    __device__ __forceinline__ void scale(int j, int par, f32x4 (&acc)[2][2][4][2], int wr, int fr) const {
#pragma unroll
        for (int ai = 0; ai < 2; ++ai)
#pragma unroll
            for (int m = 0; m < 4; ++m) { const float f = rtab[par * 1024 + (ai * HALF + wr * 64 + m * 16 + fr) * 4 + j];
#pragma unroll
                for (int bj = 0; bj < 2; ++bj)
#pragma unroll
                    for (int n = 0; n < 2; ++n) acc[ai][bj][m][n] *= f; }
    }
};
template <class Epi, class Sched, bool ALIGN_EPI = false, bool SP2 = false, class RS = NoScale>
__device__ __forceinline__ void gemm_phase(PG8_LAS unsigned char* lds, const Gemm g, const Sched& S, const Epi& E, int tid_in, const RS& R = RS()) {
    int tid_ = tid_in; asm volatile("" : "+v"(tid_));
    const int tid = tid_, wid = __builtin_amdgcn_readfirstlane(tid >> 6), lane = tid & 63, wr = wid >> 2, wc = wid & 3, fr = lane & 15, fq = lane >> 4;
    const int K = g.K, nt = K / BK;
    unsigned voffA[2], voffB[2];
#pragma unroll
    for (int i = 0; i < 2; ++i) { int R, C; stage_rc(tid * 16 + i * 8192, R, C); const int Rb = Epi::PERM ? ((R & ~31) + perm32(R & 31)) : R;
        voffA[i] = (unsigned)(R * K + C) * 2u; voffB[i] = (unsigned)(Rb * K + C) * 2u; }
    const size_t kstep = (size_t)(BK * 2);
    const size_t hstep = (size_t)HALF * K * 2;
    const size_t tstep = 2 * hstep;
    const unsigned ldsw = (unsigned)wid * 1024u;
    const int aoff = lds_byte(wr * 64 + fr, fq * 8), boff = lds_byte(wc * 32 + fr, fq * 8);
#define PG8_SA(b, h) (((b) * 2 + (h)) * HTB)
#define PG8_SB(b, h) ((4 + (b) * 2 + (h)) * HTB)
#define PG8_STAGE(bufoff, gbase, voff) do { _Pragma("unroll") for (int _i = 0; _i < 2; ++_i) \
        __builtin_amdgcn_global_load_lds((const unsigned*)((const char*)(gbase) + (voff)[_i]), (PG8_LAS unsigned*)(lds + (bufoff) + ldsw + _i * 8192), 16, 0, 0); } while (0)
#define PG8_LDA(dst, b, h) do { _Pragma("unroll") for (int m = 0; m < 4; ++m) _Pragma("unroll") for (int k = 0; k < 2; ++k) dst[m][k] = *(const PG8_LAS bf16x8*)(lds + PG8_SA(b, h) + aoff + m * 2048 + k * 1024); } while (0)
#define PG8_LDB(dst, b, h) do { _Pragma("unroll") for (int n = 0; n < 2; ++n) _Pragma("unroll") for (int k = 0; k < 2; ++k) dst[n][k] = *(const PG8_LAS bf16x8*)(lds + PG8_SB(b, h) + boff + n * 2048 + k * 1024); } while (0)
#define PG8_MMA(ai, bj, At, Bt) do { __builtin_amdgcn_s_setprio(1); _Pragma("unroll") for (int m = 0; m < 4; ++m) _Pragma("unroll") for (int n = 0; n < 2; ++n) _Pragma("unroll") for (int k = 0; k < 2; ++k) \
        acc[ai][bj][m][n] = __builtin_amdgcn_mfma_f32_16x16x32_bf16(Bt[n][k], At[m][k], acc[ai][bj][m][n], 0, 0, 0); __builtin_amdgcn_s_setprio(0); } while (0)
#define PG8_WAIT_V(n) asm volatile("s_waitcnt vmcnt(" #n ")" ::: "memory")
#define PG8_WAIT_L(n) asm volatile("s_waitcnt lgkmcnt(" #n ")" ::: "memory")
#define PG8_BAR __builtin_amdgcn_s_barrier()
#define PG8_SCHED __builtin_amdgcn_sched_barrier(0)
    Unit cur, nxt; int ui = 0;
    if (!S.next(0, cur)) return;
    f32x4 acc[2][2][4][2];
#pragma unroll
    for (int a = 0; a < 2; ++a)
#pragma unroll
        for (int b = 0; b < 2; ++b)
#pragma unroll
            for (int m = 0; m < 4; ++m)
#pragma unroll
                for (int n = 0; n < 2; ++n) acc[a][b][m][n] = (f32x4){0.f, 0.f, 0.f, 0.f};
    bf16x8 At[4][2], B0[2][2], B1[2][2];
    const char* cA = (const char*)g.A + (size_t)cur.pm * tstep; const char* cB = (const char*)g.Bt + (size_t)cur.pn * tstep;
    S.a_ready(cur);
    if constexpr (SP2) {
        PG8_STAGE(PG8_SB(0, 0), cB, voffB); PG8_STAGE(PG8_SB(0, 1), cB + hstep, voffB); PG8_STAGE(PG8_SA(0, 0), cA, voffA); PG8_STAGE(PG8_SA(0, 1), cA + hstep, voffA);
        if (wr == 1) PG8_BAR;
        PG8_WAIT_V(2); PG8_BAR;
        PG8_STAGE(PG8_SB(1, 0), cB + kstep, voffB); PG8_STAGE(PG8_SA(1, 0), cA + kstep, voffA); PG8_STAGE(PG8_SB(1, 1), cB + hstep + kstep, voffB);
        PG8_WAIT_V(6); PG8_BAR;
    } else {
        PG8_STAGE(PG8_SB(0, 0), cB, voffB); PG8_STAGE(PG8_SA(0, 0), cA, voffA); PG8_STAGE(PG8_SB(0, 1), cB + hstep, voffB); PG8_STAGE(PG8_SA(0, 1), cA + hstep, voffA);
        if (wr == 1) PG8_BAR;
        PG8_WAIT_V(4); PG8_BAR;
        PG8_STAGE(PG8_SB(1, 0), cB + kstep, voffB); PG8_STAGE(PG8_SA(1, 0), cA + kstep, voffA); PG8_STAGE(PG8_SB(1, 1), cB + hstep + kstep, voffB);
        PG8_WAIT_V(6); PG8_BAR;
    }
    for (;;) {
        const bool has_next = S.next(ui + 1, nxt);
        if constexpr (Epi::PREFETCH) E.prefetch(cur, ui & 1, wid, lane);
        const char* nA = has_next ? (const char*)g.A + (size_t)nxt.pm * tstep : cA; const char* nB = has_next ? (const char*)g.Bt + (size_t)nxt.pn * tstep : cB;
        const int tseg = RS::ON ? 4 : nt;
        for (int t0 = 0; t0 < nt; t0 += tseg) {
        if constexpr (RS::ON) { if (t0 != 0) R.scale((t0 >> 2) - 1, ui & 1, acc, wr, fr); }
        for (int t = t0; t < t0 + tseg; t += 2) {
            const bool last = (t == nt - 2);
            const char* a1 = cA + (size_t)(t + 1) * kstep;
            const char* a2 = last ? nA : cA + (size_t)(t + 2) * kstep; const char* b2 = last ? nB : cB + (size_t)(t + 2) * kstep;
            const char* a3 = a2 + kstep; const char* b3 = b2 + kstep;
            if (last && has_next) S.a_ready(nxt);
            if constexpr (SP2) {
            PG8_LDB(B0, 0, 0); PG8_LDB(B1, 0, 1); PG8_SCHED; PG8_LDA(At, 0, 0); PG8_STAGE(PG8_SA(1, 1), a1 + hstep, voffA);
            PG8_WAIT_V(8); PG8_WAIT_L(0); PG8_BAR; PG8_MMA(0, 0, At, B0); PG8_MMA(0, 1, At, B1); PG8_BAR; PG8_SCHED;
            PG8_LDA(At, 0, 1); PG8_STAGE(PG8_SB(0, 0), b2, voffB); PG8_STAGE(PG8_SB(0, 1), b2 + hstep, voffB); PG8_STAGE(PG8_SA(0, 0), a2, voffA);
            PG8_WAIT_V(8); PG8_WAIT_L(0); PG8_BAR; PG8_MMA(1, 0, At, B0); PG8_MMA(1, 1, At, B1); PG8_BAR; PG8_SCHED;
            PG8_LDB(B0, 1, 0); PG8_LDB(B1, 1, 1); PG8_SCHED; PG8_LDA(At, 1, 0); PG8_STAGE(PG8_SA(0, 1), a2 + hstep, voffA);
            PG8_WAIT_V(8); PG8_WAIT_L(0); PG8_BAR; PG8_MMA(0, 0, At, B0); PG8_MMA(0, 1, At, B1); PG8_BAR; PG8_SCHED;
            PG8_LDA(At, 1, 1); PG8_STAGE(PG8_SB(1, 0), b3, voffB); PG8_STAGE(PG8_SB(1, 1), b3 + hstep, voffB); PG8_STAGE(PG8_SA(1, 0), a3, voffA);
            PG8_WAIT_V(8); PG8_WAIT_L(0); PG8_BAR; PG8_MMA(1, 0, At, B0); PG8_MMA(1, 1, At, B1); PG8_BAR; PG8_SCHED;
            } else {
            PG8_LDB(B0, 0, 0); PG8_SCHED; PG8_LDA(At, 0, 0); PG8_STAGE(PG8_SA(1, 1), a1 + hstep, voffA);
            PG8_WAIT_L(8); PG8_BAR; PG8_WAIT_L(0); PG8_MMA(0, 0, At, B0); PG8_BAR; PG8_SCHED;
            PG8_LDB(B1, 0, 1); PG8_STAGE(PG8_SB(0, 0), b2, voffB);
            PG8_BAR; PG8_WAIT_L(0); PG8_MMA(0, 1, At, B1); PG8_BAR;
            PG8_LDA(At, 0, 1); PG8_STAGE(PG8_SA(0, 0), a2, voffA);
            PG8_BAR; PG8_WAIT_L(0); PG8_MMA(1, 0, At, B0); PG8_BAR; PG8_SCHED;
            PG8_STAGE(PG8_SB(0, 1), b2 + hstep, voffB);
            PG8_WAIT_V(6); PG8_BAR; PG8_MMA(1, 1, At, B1); PG8_BAR;
            PG8_LDB(B0, 1, 0); PG8_SCHED; PG8_LDA(At, 1, 0); PG8_STAGE(PG8_SA(0, 1), a2 + hstep, voffA);
            PG8_WAIT_L(8); PG8_BAR; PG8_WAIT_L(0); PG8_MMA(0, 0, At, B0); PG8_BAR; PG8_SCHED;
            PG8_LDB(B1, 1, 1); PG8_STAGE(PG8_SB(1, 0), b3, voffB);
            PG8_BAR; PG8_WAIT_L(0); PG8_MMA(0, 1, At, B1); PG8_BAR;
            PG8_LDA(At, 1, 1); PG8_STAGE(PG8_SA(1, 0), a3, voffA);
            PG8_BAR; PG8_WAIT_L(0); PG8_MMA(1, 0, At, B0); PG8_BAR; PG8_SCHED;
            PG8_STAGE(PG8_SB(1, 1), b3 + hstep, voffB);
            PG8_WAIT_V(6); PG8_BAR; PG8_MMA(1, 1, At, B1); PG8_BAR;
            }
        }
        }
        if constexpr (ALIGN_EPI) { if (wr == 0) PG8_BAR; }
        if constexpr (RS::ON) R.scale(3, ui & 1, acc, wr, fr);
        if constexpr (!Epi::AFTER_DRAIN) { if constexpr (Epi::PREFETCH) E(acc, cur, wr, wc, fr, fq, ui & 1); else E(acc, cur, wr, wc, fr, fq); S.done(cur); }
        if (!has_next) break;
#pragma unroll
        for (int a = 0; a < 2; ++a)
#pragma unroll
            for (int b = 0; b < 2; ++b)
#pragma unroll
                for (int m = 0; m < 4; ++m)
#pragma unroll
                    for (int n = 0; n < 2; ++n) acc[a][b][m][n] = (f32x4){0.f, 0.f, 0.f, 0.f};
        cur = nxt; cA = nA; cB = nB; ++ui;
        if constexpr (ALIGN_EPI) { if (wr == 1) PG8_BAR; }
    }
    PG8_WAIT_V(0);
    if constexpr (!ALIGN_EPI) { if (wr == 0) PG8_BAR; }
    PG8_BAR;
    if constexpr (Epi::AFTER_DRAIN) { E.fused(acc, cur, wr, wc, fr, fq, lds, wid, lane); S.done(cur); }
#undef PG8_SA
#undef PG8_SB
#undef PG8_STAGE
#undef PG8_LDA
#undef PG8_LDB
#undef PG8_MMA
#undef PG8_WAIT_V
#undef PG8_WAIT_L
#undef PG8_BAR
#undef PG8_SCHED
}
}
#include <hip/hip_bf16.h>
#include <cmath>
namespace attn_body {
using bf16=__hip_bfloat16;
using bf16x8=__attribute__((ext_vector_type(8)))short;
using s16x4=__attribute__((ext_vector_type(4)))short;
using f32x16=__attribute__((ext_vector_type(16)))float;
using u32x4=__attribute__((ext_vector_type(4)))unsigned;
constexpr int BATCH=2,NHEAD=4,SEQ=16384,D=64;
constexpr int QP=2048,KP=128,VP=2048,OP=1024;
constexpr int NW=8,QBLK=32,QB=QBLK*NW,KVBLK=64,NQB=SEQ/QB;
constexpr int ATTN_UNIT_ROWS=QB;
__device__ __forceinline__ int crow(int r,int hi){return (r&3)+8*(r>>2)+4*hi;}
#define SBAR() __builtin_amdgcn_sched_barrier(0)
__device__ __forceinline__ void cmask(f32x16&p0,f32x16&p1,int jb,int qrel,int hi){
  const float NEG=-INFINITY; int kb=64*jb+4*hi;
  #pragma unroll
  for(int r=0;r<16;++r){int kv=kb+(r&3)+8*(r>>2); if(kv>qrel)p0[r]=NEG; if(kv+32>qrel)p1[r]=NEG;}
}

constexpr int NSLOT=3, SLOTB=8192;
constexpr int LDS_K=0, LDS_V=NSLOT*SLOTB, LDS_WS=2*NSLOT*SLOTB, LDS_OST=LDS_WS+NW*64*4, LDS_BYTES=LDS_OST+NW*4096;
constexpr float C2=0.125f*1.4426950408889634f;
__device__ __forceinline__ void glds16(const void*gsrc,unsigned lds_dst){unsigned keep;
  asm volatile("s_mov_b32 %0, m0\n\ts_mov_b32 m0, %2\n\ts_nop 0\n\tglobal_load_lds_dwordx4 %1, off\n\ts_mov_b32 m0, %0":"=&s"(keep):"v"(gsrc),"s"(lds_dst):"memory");}
__device__ __forceinline__ float max3f(float a,float b,float c){float r;asm("v_max3_f32 %0, %1, %2, %3":"=v"(r):"v"(a),"v"(b),"v"(c));return r;}
__device__ __forceinline__ float max2f(float a,float b){float r;asm("v_max_f32_e32 %0, %1, %2":"=v"(r):"v"(a),"v"(b));return r;}
__device__ __forceinline__ float fadd_s(float a,float b){float r;asm("v_add_f32_e32 %0, %1, %2":"=v"(r):"v"(a),"v"(b));return r;}
__device__ __forceinline__ float fsub_s(float a,float b){float r;asm("v_sub_f32_e32 %0, %1, %2":"=v"(r):"v"(a),"v"(b));return r;}
typedef float f32x2_t __attribute__((ext_vector_type(2))); typedef __bf16 bf16x2_t __attribute__((ext_vector_type(2)));
__device__ __forceinline__ unsigned cvtpk_s(float lo,float hi){f32x2_t v={lo,hi};bf16x2_t b=__builtin_convertvector(v,bf16x2_t);return __builtin_bit_cast(unsigned,b);}
#define WAIT_BAR(N) asm volatile("s_waitcnt vmcnt(" #N ") lgkmcnt(0)\n\ts_barrier":::"memory")

__device__ __forceinline__ void qkt(f32x16&p0,f32x16&p1,const char*Kslot,const bf16x8*qr,const f32x16&negm,int r32,int hi){
  const char*kb=Kslot+hi*1024+r32*16;
  #pragma unroll
  for(int d0=0;d0<4;++d0){
    const bf16x8 b0=*reinterpret_cast<const bf16x8*>(kb+d0*2048);
    const bf16x8 b1=*reinterpret_cast<const bf16x8*>(kb+d0*2048+512);
    if(d0==0){p0=__builtin_amdgcn_mfma_f32_32x32x16_bf16(b0,qr[0],negm,0,0,0);p1=__builtin_amdgcn_mfma_f32_32x32x16_bf16(b1,qr[0],negm,0,0,0);}
    else{p0=__builtin_amdgcn_mfma_f32_32x32x16_bf16(b0,qr[d0],p0,0,0,0);p1=__builtin_amdgcn_mfma_f32_32x32x16_bf16(b1,qr[d0],p1,0,0,0);}}
}
typedef __attribute__((address_space(3))) const char* lds_cptr;
typedef short v4i16_t __attribute__((ext_vector_type(4)));
__device__ __forceinline__ void kload8(bf16x8*kf,lds_cptr kp){
  kf[0]=*(const __attribute__((address_space(3))) bf16x8*)(kp);      kf[1]=*(const __attribute__((address_space(3))) bf16x8*)(kp+512);
  kf[2]=*(const __attribute__((address_space(3))) bf16x8*)(kp+2048); kf[3]=*(const __attribute__((address_space(3))) bf16x8*)(kp+2560);
  kf[4]=*(const __attribute__((address_space(3))) bf16x8*)(kp+4096); kf[5]=*(const __attribute__((address_space(3))) bf16x8*)(kp+4608);
  kf[6]=*(const __attribute__((address_space(3))) bf16x8*)(kp+6144); kf[7]=*(const __attribute__((address_space(3))) bf16x8*)(kp+6656);
}
__device__ __forceinline__ void kload2(bf16x8*kf,lds_cptr kp,int j){ kf[2*j]=*(const __attribute__((address_space(3))) bf16x8*)(kp+j*2048); kf[2*j+1]=*(const __attribute__((address_space(3))) bf16x8*)(kp+j*2048+512); }
__device__ __forceinline__ s16x4 vtr(lds_cptr p){ return __builtin_bit_cast(s16x4,__builtin_amdgcn_ds_read_tr16_b64_v4i16((__attribute__((address_space(3))) v4i16_t*)p)); }
__device__ __forceinline__ float rowmax(const f32x16&p0,const f32x16&p1){
  float a=max3f(p0[0],p0[1],p1[0]),b=max3f(p0[2],p0[3],p1[1]);a=max3f(a,p1[2],p1[3]);
  #pragma unroll
  for(int r=4;r<16;r+=4){a=max3f(a,p0[r],p0[r+1]);b=max3f(b,p0[r+2],p0[r+3]);a=max3f(a,p1[r],p1[r+1]);b=max3f(b,p1[r+2],p1[r+3]);}
  const float m=max2f(a,b);
  auto rr=__builtin_amdgcn_permlane32_swap(__float_as_uint(m),__float_as_uint(m),false,false);
  return max2f(__uint_as_float(rr[0]),__uint_as_float(rr[1]));
}
__device__ __forceinline__ void pv(f32x16*o,int vb,bf16x8 pa0,bf16x8 pa1,bf16x8 pa2,bf16x8 pa3){
  #pragma unroll
  for(int d0=0;d0<2;++d0){s16x4 lo[4],hi[4];
    #pragma unroll
    for(int ks=0;ks<4;++ks){
      asm volatile("ds_read_b64_tr_b16 %0,%1 offset:%c2":"=&v"(lo[ks]):"v"(vb),"i"(d0*4096+ks*1024):"memory");
      asm volatile("ds_read_b64_tr_b16 %0,%1 offset:%c2":"=&v"(hi[ks]):"v"(vb),"i"(d0*4096+ks*1024+512):"memory");}
    asm volatile("s_waitcnt lgkmcnt(0)":::"memory");SBAR();
    #define PK(k) (bf16x8){lo[k][0],lo[k][1],lo[k][2],lo[k][3],hi[k][0],hi[k][1],hi[k][2],hi[k][3]}
    o[d0]=__builtin_amdgcn_mfma_f32_32x32x16_bf16(pa0,PK(0),o[d0],0,0,0);
    o[d0]=__builtin_amdgcn_mfma_f32_32x32x16_bf16(pa1,PK(1),o[d0],0,0,0);
    o[d0]=__builtin_amdgcn_mfma_f32_32x32x16_bf16(pa2,PK(2),o[d0],0,0,0);
    o[d0]=__builtin_amdgcn_mfma_f32_32x32x16_bf16(pa3,PK(3),o[d0],0,0,0);
    #undef PK
  }
}

#ifndef ATTN_STORE16
#define ATTN_STORE16(p,v) (*(u32x4*)(p)=(v))
#endif
template<int THRL> __device__ __forceinline__ void attn_unit(int b,int h,int qb,const bf16*Q,const bf16*__restrict__ K,const bf16*__restrict__ V,bf16*O,char*shm,const float*__restrict__ qg,const float*__restrict__ kg,fx_t*ssq,int tid_in){
  int tid_=tid_in; asm volatile("":"+v"(tid_)); const int tid=tid_,lane=tid&63,r32=lane&31,hi=lane>>5; const int wid=__builtin_amdgcn_readfirstlane(tid>>6);
  const long rowbase=(long)b*SEQ; const int q0=qb*QB;
  const bf16*Qw=Q+(rowbase+q0+wid*QBLK)*QP+h*D;
  const bf16*Kh=K+rowbase*KP+(h>>1)*D,*Vh=V+rowbase*VP+(h>>1)*D;
  const unsigned lds0=(unsigned)(uintptr_t)shm;
  float*wsf=(float*)(shm+LDS_WS)+wid*64;
  const bf16*ksrc=Kh+(long)lane*KP+wid*8;
  const bf16*vsrc=Vh+(long)(16*(wid&3)+(lane>>2))*VP+(wid>>2)*32+(lane&3)*8;
  const unsigned kdst=lds0+LDS_K+wid*1024, vdst=lds0+LDS_V+wid*1024;
  #define DMA_K(t,slot) glds16(ksrc+(long)(t)*KVBLK*KP,(unsigned)__builtin_amdgcn_readfirstlane(kdst+(slot)))
  #define DMA_V(t,slot) glds16(vsrc+(long)(t)*KVBLK*VP,(unsigned)__builtin_amdgcn_readfirstlane(vdst+(slot)))
  const int vb0=(int)(lds0+LDS_V)+((lane>>4)&1)*32+(lane&3)*8+(4*hi+((lane&15)>>2))*64;
  const char*Kbase=shm+LDS_K; bf16x8 kf[8];
  const lds_cptr shm3=(lds_cptr)shm; const lds_cptr kp0=shm3+LDS_K+hi*1024+r32*16; const lds_cptr vp0=shm3+LDS_V+((lane>>4)&1)*32+(lane&3)*8+(4*hi+((lane&15)>>2))*64;
  const int NT=SEQ/KVBLK;
  DMA_K(0,0);DMA_V(0,0);DMA_K(1,SLOTB);
  bf16x8 qr[4];
  { float xq[4][8]; float ss=0.f;
    #pragma unroll
    for(int d0=0;d0<4;++d0){ const bf16x8 raw=*reinterpret_cast<const bf16x8*>(&Qw[(long)r32*QP+d0*16+hi*8]);
      #pragma unroll
      for(int e=0;e<8;++e){ const float v=__builtin_bit_cast(float,((unsigned)(unsigned short)raw[e])<<16); xq[d0][e]=v; ss+=v*v; } }
    { auto rr=__builtin_amdgcn_permlane32_swap(__float_as_uint(ss),__float_as_uint(ss),false,false); ss=__uint_as_float(rr[0])+__uint_as_float(rr[1]); }
    const float rstd=C2/sqrtf(ss*(1.0f/64.0f)+1e-6f);
    const int tq=q0+wid*QBLK+r32; const float prow=(float)(tq>>6), pcol=(float)(tq&63);
    #pragma unroll
    for(int d0=0;d0<4;++d0)
      #pragma unroll
      for(int e=0;e<8;++e) xq[d0][e]*=rstd*qg[d0*16+hi*8+e];
    #pragma unroll
    for(int sg=0;sg<2;++sg){ const float pos=sg?pcol:prow;
      #pragma unroll
      for(int e=0;e<8;++e){ const float invf=__builtin_amdgcn_exp2f(-(float)(8*hi+e)*0.83048202372184f); const float rev=pos*invf*0.15915494309189535f;
        const float c=__builtin_amdgcn_cosf(rev), s=__builtin_amdgcn_sinf(rev);
        const float x1=xq[2*sg][e], x2=xq[2*sg+1][e]; xq[2*sg][e]=x1*c-x2*s; xq[2*sg+1][e]=x2*c+x1*s; } }
    #pragma unroll
    for(int d0=0;d0<4;++d0){ u32x4 w; w[0]=cvtpk_s(xq[d0][0],xq[d0][1]); w[1]=cvtpk_s(xq[d0][2],xq[d0][3]); w[2]=cvtpk_s(xq[d0][4],xq[d0][5]); w[3]=cvtpk_s(xq[d0][6],xq[d0][7]); qr[d0]=__builtin_bit_cast(bf16x8,w); } }
  float mref; { float a=__builtin_fabsf(qg[lane]), b=__builtin_fabsf(kg[lane]);
    #pragma unroll
    for(int o_=1;o_<64;o_<<=1){ a=__builtin_fmaxf(a,__shfl_xor(a,o_)); b=__builtin_fmaxf(b,__shfl_xor(b,o_)); }
    mref=__builtin_fminf(60.f,11.541560327f*a*b); }
  float l_reg=0.f;f32x16 o[2];o[0]=f32x16{};o[1]=f32x16{};f32x16 negm;
  #pragma unroll
  for(int r=0;r<16;++r)negm[r]=-mref;
  asm volatile("":"+v"(negm));
  const int qrel=wid*QBLK+r32;
  #define CMASK(P0,P1,t) do{}while(0)
  bool resc=false;
  #define START(P0,P1) do{ _Pragma("unroll") for(int r=0;r<16;++r)P0[r]=__builtin_amdgcn_exp2f(P0[r]); }while(0)
  #define RESC() do{ if(resc){ asm volatile("s_waitcnt lgkmcnt(0)":::"memory"); \
      _Pragma("unroll") for(int d_=0;d_<2;++d_) _Pragma("unroll") for(int r=0;r<16;++r)o[d_][r]*=wsf[crow(r,hi)]; } }while(0)
  f32x16 pA0,pA1,pB0,pB1;
  int sl_prev=0,sl_cur=0,sl_next=SLOTB;
  #define ROT() do{sl_prev=sl_cur;sl_cur=sl_next;sl_next=(sl_next==(NSLOT-1)*SLOTB)?0:sl_next+SLOTB;}while(0)
  DMA_K(2,2*SLOTB);
  WAIT_BAR(3);
  qkt(pA0,pA1,Kbase,qr,negm,r32,hi);asm volatile("s_nop 15\n\ts_nop 7":"+v"(pA0),"+v"(pA1));CMASK(pA0,pA1,0);
  START(pA0,pA1);
  _Pragma("unroll") for(int r=0;r<16;++r)pA1[r]=__builtin_amdgcn_exp2f(pA1[r]);
  WAIT_BAR(0);
  DMA_K(3,0);DMA_V(1,SLOTB);
  ROT();
  kload8(kf,kp0+sl_cur);
  WAIT_BAR(2);
  s16x4 vlo[8],vhi[8]; u32x4 pw0,pw1,pw2,pw3;
  #define PKW(P,B) cvtpk_s(P[B],P[B+1])
  #define PAF(k) __builtin_bit_cast(bf16x8,pw##k)
  #define VFR(i) (bf16x8){vlo[i][0],vlo[i][1],vlo[i][2],vlo[i][3],vhi[i][0],vhi[i][1],vhi[i][2],vhi[i][3]}
  #define PIN(x) asm volatile("":"+v"(x))
  #define MX3(a,b,c) __builtin_fmaxf(__builtin_fmaxf((a),(b)),(c))
  #define GAPA(MF,A0,A1,A2,A3,W0,W1,PW) do{ MF; sacc+=A0; sacc+=A1; sacc+=A2; sacc+=A3; PIN(sacc); W0; W1; PIN(PW); SBAR(); }while(0)
  #define EX(v) __builtin_amdgcn_exp2f(v)
  #define GAPB(MF,X,B) do{ MF; X[B]=EX(X[B]); X[B+1]=EX(X[B+1]); X[B+2]=EX(X[B+2]); X[B+3]=EX(X[B+3]); PIN(X); SBAR(); }while(0)
  #define VRD(i) do{ vlo[i]=vtr(vp_+(((i)>>2)*4096+((i)&3)*1024)); vhi[i]=vtr(vp_+(((i)>>2)*4096+((i)&3)*1024+512)); }while(0)
  #define KRD(G,j) do{ if(G){ kload2(kf,kp0+sl_next,j); SBAR(); } }while(0)
  #define STEP(C0,C1,P0,P1,t,GK,GV,GL) do{ SBAR(); \
    const lds_cptr vp_=vp0+sl_prev; \
    VRD(0); SBAR(); float sacc=(P0[0]+P0[1]); \
    GAPA(C0=__builtin_amdgcn_mfma_f32_32x32x16_bf16(kf[0],qr[0],negm,0,0,0), P0[2],P0[3],P0[4],P0[5],     pw0[0]=PKW(P0,0), pw0[1]=PKW(P0,2), pw0); \
    VRD(4); SBAR(); GAPA(C1=__builtin_amdgcn_mfma_f32_32x32x16_bf16(kf[1],qr[0],negm,0,0,0), P0[6],P0[7],P0[8],P0[9],     pw0[2]=PKW(P0,4), pw0[3]=PKW(P0,6), pw0); \
    VRD(1); SBAR(); GAPA(C0=__builtin_amdgcn_mfma_f32_32x32x16_bf16(kf[2],qr[1],C0,0,0,0),   P0[10],P0[11],P0[12],P0[13], pw1[0]=PKW(P0,8), pw1[1]=PKW(P0,10), pw1); \
    VRD(5); SBAR(); GAPA(C1=__builtin_amdgcn_mfma_f32_32x32x16_bf16(kf[3],qr[1],C1,0,0,0),   P0[14],P0[15],P1[0],P1[1],   pw1[2]=PKW(P0,12),pw1[3]=PKW(P0,14), pw1); \
    VRD(2); SBAR(); GAPA(C0=__builtin_amdgcn_mfma_f32_32x32x16_bf16(kf[4],qr[2],C0,0,0,0),   P1[2],P1[3],P1[4],P1[5],     pw2[0]=PKW(P1,0), pw2[1]=PKW(P1,2), pw2); \
    VRD(6); SBAR(); GAPA(C1=__builtin_amdgcn_mfma_f32_32x32x16_bf16(kf[5],qr[2],C1,0,0,0),   P1[6],P1[7],P1[8],P1[9],     pw2[2]=PKW(P1,4), pw2[3]=PKW(P1,6), pw2); \
    VRD(3); SBAR(); GAPA(C0=__builtin_amdgcn_mfma_f32_32x32x16_bf16(kf[6],qr[3],C0,0,0,0),   P1[10],P1[11],P1[12],P1[13], pw3[0]=PKW(P1,8), pw3[1]=PKW(P1,10), pw3); \
    VRD(7); SBAR(); GAPA(C1=__builtin_amdgcn_mfma_f32_32x32x16_bf16(kf[7],qr[3],C1,0,0,0),   P1[14],P1[15],0.f,0.f,       pw3[2]=PKW(P1,12),pw3[3]=PKW(P1,14), pw3); \
    l_reg+=sacc; \
    if(GK){DMA_K((t)+3,sl_cur);} if(GV){DMA_V((t)+1,sl_next);} \
    CMASK(C0,C1,t); \
    SBAR(); \
    GAPB(o[0]=__builtin_amdgcn_mfma_f32_32x32x16_bf16(PAF(0),VFR(0),o[0],0,0,0), C0,0); \
    GAPB(o[1]=__builtin_amdgcn_mfma_f32_32x32x16_bf16(PAF(0),VFR(4),o[1],0,0,0), C0,4); \
    KRD(GL,0); GAPB(o[0]=__builtin_amdgcn_mfma_f32_32x32x16_bf16(PAF(1),VFR(1),o[0],0,0,0), C0,8); \
    KRD(GL,1); GAPB(o[1]=__builtin_amdgcn_mfma_f32_32x32x16_bf16(PAF(1),VFR(5),o[1],0,0,0), C0,12); \
    KRD(GL,2); GAPB(o[0]=__builtin_amdgcn_mfma_f32_32x32x16_bf16(PAF(2),VFR(2),o[0],0,0,0), C1,0); \
    KRD(GL,3); GAPB(o[1]=__builtin_amdgcn_mfma_f32_32x32x16_bf16(PAF(2),VFR(6),o[1],0,0,0), C1,4); \
    GAPB(o[0]=__builtin_amdgcn_mfma_f32_32x32x16_bf16(PAF(3),VFR(3),o[0],0,0,0), C1,8); \
    GAPB(o[1]=__builtin_amdgcn_mfma_f32_32x32x16_bf16(PAF(3),VFR(7),o[1],0,0,0), C1,12); \
    }while(0)
  int t=1;
  #undef CMASK
  #define CMASK(P0,P1,t) do{}while(0)
  for(;t+5<NT;t+=2){
    STEP(pB0,pB1,pA0,pA1,t,true,true,true);     WAIT_BAR(2); RESC(); ROT();
    STEP(pA0,pA1,pB0,pB1,t+1,true,true,true);   WAIT_BAR(2); RESC(); ROT();
  }
  #undef CMASK
  #define CMASK(P0,P1,t) do{}while(0)
  #define ENDW(tt) do{ if((tt)+3<NT){WAIT_BAR(2);} else if((tt)+2<NT){WAIT_BAR(1);} else {WAIT_BAR(0);} }while(0)
  for(;t+1<NT;t+=2){
    STEP(pB0,pB1,pA0,pA1,t,(t+3<NT),(t+1<NT),(t+1<NT));       ENDW(t);   RESC(); ROT();
    STEP(pA0,pA1,pB0,pB1,t+1,(t+4<NT),(t+2<NT),(t+2<NT));     ENDW(t+1); RESC(); ROT();
  }
  STEP(pB0,pB1,pA0,pA1,NT-1,false,false,false); RESC();
  { float sacc=pB0[0]+pB0[1]; _Pragma("unroll") for(int r=2;r<16;++r)sacc+=pB0[r]; _Pragma("unroll") for(int r=0;r<16;++r)sacc+=pB1[r]; l_reg+=sacc;
    pw0=(u32x4){PKW(pB0,0),PKW(pB0,2),PKW(pB0,4),PKW(pB0,6)};pw1=(u32x4){PKW(pB0,8),PKW(pB0,10),PKW(pB0,12),PKW(pB0,14)};pw2=(u32x4){PKW(pB1,0),PKW(pB1,2),PKW(pB1,4),PKW(pB1,6)};pw3=(u32x4){PKW(pB1,8),PKW(pB1,10),PKW(pB1,12),PKW(pB1,14)};
    SBAR(); pv(o,vb0+sl_cur,PAF(0),PAF(1),PAF(2),PAF(3)); }
  #undef PKW
  #undef PAF
  #undef VFR
  #undef PIN
  #undef MX3
  #undef GAPA
  #undef GAPB
  #undef EX
  #undef VRD
  #undef KRD
  #undef STEP
  #undef ENDW
  {auto rr=__builtin_amdgcn_permlane32_swap(__float_as_uint(l_reg),__float_as_uint(l_reg),false,false);l_reg=__uint_as_float(rr[0])+__uint_as_float(rr[1]);}
  if(hi==0)wsf[32+r32]=l_reg;asm volatile("s_waitcnt lgkmcnt(0)":::"memory");
  float rli[16];
  #pragma unroll
  for(int r=0;r<16;++r)rli[r]=__builtin_amdgcn_rcpf(wsf[32+crow(r,hi)]);
  bf16*Ow=O+(rowbase+q0+wid*QBLK)*OP+h*D;
  { bf16*stg=(bf16*)(shm+LDS_OST)+wid*2048;
    #pragma unroll
    for(int r=0;r<16;++r){const int orow=crow(r,hi);
      #pragma unroll
      for(int d0=0;d0<2;++d0)stg[orow*64+d0*32+r32]=__float2bfloat16(o[d0][r]*rli[r]);}
    asm volatile("s_waitcnt lgkmcnt(0)":::"memory");
    #pragma unroll
    for(int i=0;i<4;++i){const int row=i*8+(lane>>3),ch=lane&7; const u32x4 v=*(const u32x4*)(stg+row*64+ch*8); ATTN_STORE16(Ow+(long)row*OP+ch*8,v);
      float sq=0.f;
      #pragma unroll
      for(int e=0;e<4;++e){ const float lo=__uint_as_float(v[e]<<16), hh=__uint_as_float(v[e]&0xffff0000u); sq+=lo*lo+hh*hh; }
      sq+=__shfl_xor(sq,1); sq+=__shfl_xor(sq,2); sq+=__shfl_xor(sq,4);
      if(ch==0) fx_atomic_add(ssq+4*(rowbase+q0+wid*QBLK+row), fx_from(sq,FX_SQ)); } }
  asm volatile("s_waitcnt lgkmcnt(0)\n\ts_barrier":::"memory");
  #undef DMA_K
  #undef DMA_V
  #undef CMASK
  #undef START
  #undef RESC
  #undef ROT
}

__device__ __forceinline__ void q_frags(bf16x8*qr,const bf16*Qrow,const float*__restrict__ qg,int tq,int hi){
  float xq[4][8]; float ss=0.f;
  #pragma unroll
  for(int d0=0;d0<4;++d0){ const bf16x8 raw=*reinterpret_cast<const bf16x8*>(&Qrow[d0*16+hi*8]);
    #pragma unroll
    for(int e=0;e<8;++e){ const float v=__builtin_bit_cast(float,((unsigned)(unsigned short)raw[e])<<16); xq[d0][e]=v; ss+=v*v; } }
  { auto rr=__builtin_amdgcn_permlane32_swap(__float_as_uint(ss),__float_as_uint(ss),false,false); ss=__uint_as_float(rr[0])+__uint_as_float(rr[1]); }
  const float rstd=C2/sqrtf(ss*(1.0f/64.0f)+1e-6f);
  const float prow=(float)(tq>>6), pcol=(float)(tq&63);
  #pragma unroll
  for(int d0=0;d0<4;++d0)
    #pragma unroll
    for(int e=0;e<8;++e) xq[d0][e]*=rstd*qg[d0*16+hi*8+e];
  #pragma unroll
  for(int sg=0;sg<2;++sg){ const float pos=sg?pcol:prow;
    #pragma unroll
    for(int e=0;e<8;++e){ const float invf=__builtin_amdgcn_exp2f(-(float)(8*hi+e)*0.83048202372184f); const float rev=pos*invf*0.15915494309189535f;
      const float c=__builtin_amdgcn_cosf(rev), s=__builtin_amdgcn_sinf(rev);
      const float x1=xq[2*sg][e], x2=xq[2*sg+1][e]; xq[2*sg][e]=x1*c-x2*s; xq[2*sg+1][e]=x2*c+x1*s; } }
  #pragma unroll
  for(int d0=0;d0<4;++d0){ u32x4 w; w[0]=cvtpk_s(xq[d0][0],xq[d0][1]); w[1]=cvtpk_s(xq[d0][2],xq[d0][3]); w[2]=cvtpk_s(xq[d0][4],xq[d0][5]); w[3]=cvtpk_s(xq[d0][6],xq[d0][7]); qr[d0]=__builtin_bit_cast(bf16x8,w); }
}
constexpr int A64_LDS_V=NSLOT*SLOTB;
__device__ __forceinline__ void glds16s(const void*sbase,unsigned voff,unsigned lds_dst){unsigned keep;
  asm volatile("s_mov_b32 %0, m0\n\ts_mov_b32 m0, %3\n\ts_nop 0\n\tglobal_load_lds_dwordx4 %1, %2\n\ts_mov_b32 m0, %0":"=&s"(keep):"v"(voff),"s"(sbase),"s"(lds_dst):"memory");}
__device__ __forceinline__ void attn_unit64(int b,int h,int qb,const bf16*Q,const bf16*__restrict__ K,const bf16*__restrict__ V,bf16*O,char*shm,const float*__restrict__ qg,const float*__restrict__ kg,fx_t*ssq,int wid_s){
  int tid_; asm volatile("v_mbcnt_lo_u32_b32 %0, -1, 0\n\tv_mbcnt_hi_u32_b32 %0, -1, %0\n\tv_lshl_or_b32 %0, %1, 6, %0":"=&v"(tid_):"s"(wid_s)); const int tid=tid_,lane=tid&63,r32=lane&31,hi=lane>>5; const int wid=wid_s;
  const long rowbase=(long)b*SEQ; const int q0=qb*512+wid*64;
  const bf16*Kh=K+rowbase*KP+(h>>1)*D,*Vh=V+rowbase*VP+(h>>1)*D;
  const unsigned lds0=(unsigned)(uintptr_t)shm;
  const unsigned koff=(unsigned)((lane*KP+wid*8)*2);
  const unsigned voff=(unsigned)(((16*(wid&3)+(lane>>2))*VP+(wid>>2)*32+(lane&3)*8)*2);
  constexpr int S2B=2*SLOTB, LDSV2=3*S2B;
  const unsigned kdst=lds0+wid*1024, vdst=lds0+LDSV2+wid*1024;
  #define DMA64(t,slot) do{ glds16s(Kh+(long)(2*(t))*KVBLK*KP,koff,(unsigned)__builtin_amdgcn_readfirstlane(kdst+(slot))); glds16s(Kh+(long)(2*(t)+1)*KVBLK*KP,koff,(unsigned)__builtin_amdgcn_readfirstlane(kdst+(slot)+SLOTB)); \
    glds16s(Vh+(long)(2*(t))*KVBLK*VP,voff,(unsigned)__builtin_amdgcn_readfirstlane(vdst+(slot))); glds16s(Vh+(long)(2*(t)+1)*KVBLK*VP,voff,(unsigned)__builtin_amdgcn_readfirstlane(vdst+(slot)+SLOTB)); }while(0)
  const lds_cptr shm3=(lds_cptr)shm; const lds_cptr kp0=shm3+hi*1024+r32*16; const lds_cptr vp0=shm3+LDSV2+((lane>>4)&1)*32+(lane&3)*8+(4*hi+((lane&15)>>2))*64;
  bf16x8 q0f[4],q1f[4];
  q_frags(q0f,Q+(rowbase+q0+r32)*QP+h*D,qg,q0+r32,hi); asm volatile("":"+v"(q0f[0]),"+v"(q0f[1]),"+v"(q0f[2]),"+v"(q0f[3])); SBAR();
  q_frags(q1f,Q+(rowbase+q0+32+r32)*QP+h*D,qg,q0+32+r32,hi); asm volatile("":"+v"(q1f[0]),"+v"(q1f[1]),"+v"(q1f[2]),"+v"(q1f[3])); SBAR();
  constexpr int NT=SEQ/(2*KVBLK);
  DMA64(0,0); DMA64(1,S2B);
  const f32x16 zero16=f32x16{};
  f32x16 ot00=f32x16{},ot01=f32x16{},ot10=f32x16{},ot11=f32x16{}; float l0=0.f,l1=0.f;
  asm volatile("s_waitcnt vmcnt(0)\n\ts_barrier":::"memory");
  typedef const __attribute__((address_space(3))) bf16x8* kfp_t;
  #define KLD(dst,base) do{ dst[0]=*(kfp_t)((base)); dst[1]=*(kfp_t)((base)+2048); dst[2]=*(kfp_t)((base)+4096); dst[3]=*(kfp_t)((base)+6144); }while(0)
  #define EX4(S,B) do{ S[B]=__builtin_amdgcn_exp2f(S[B]); S[B+1]=__builtin_amdgcn_exp2f(S[B+1]); S[B+2]=__builtin_amdgcn_exp2f(S[B+2]); S[B+3]=__builtin_amdgcn_exp2f(S[B+3]); }while(0)
  #define PK8(S,B) (u32x4){cvtpk_s(S[B],S[B+1]),cvtpk_s(S[B+2],S[B+3]),cvtpk_s(S[B+4],S[B+5]),cvtpk_s(S[B+6],S[B+7])}
  #define SUM4(A,S,B) do{ A+=(S[B]+S[B+1])+(S[B+2]+S[B+3]); }while(0)
  #define MF(a,b,c) __builtin_amdgcn_mfma_f32_32x32x16_bf16(a,b,c,0,0,0)
  #define VF(lo,hi_) (bf16x8){lo[0],lo[1],lo[2],lo[3],hi_[0],hi_[1],hi_[2],hi_[3]}
  #define HALFSTEP(SC0,SC1,SN0,SN1,VP_,KS,KNEXT) do{ \
    const s16x4 v0l=vtr((VP_)+(KS)*1024), v0h=vtr((VP_)+(KS)*1024+512), v1l=vtr((VP_)+4096+(KS)*1024), v1h=vtr((VP_)+4096+(KS)*1024+512); SBAR(); \
    SN0=MF(kf[0],q0f[0],zero16); EX4(SC0,0);  SBAR(); \
    SN1=MF(kf[0],q1f[0],zero16); EX4(SC0,4);  SBAR(); \
    SN0=MF(kf[1],q0f[1],SN0);  EX4(SC0,8);  SBAR(); \
    SN1=MF(kf[1],q1f[1],SN1);  EX4(SC0,12); SBAR(); \
    SN0=MF(kf[2],q0f[2],SN0);  EX4(SC1,0);  SBAR(); \
    SN1=MF(kf[2],q1f[2],SN1);  EX4(SC1,4);  SBAR(); \
    SN0=MF(kf[3],q0f[3],SN0);  EX4(SC1,8);  SBAR(); \
    SN1=MF(kf[3],q1f[3],SN1);  EX4(SC1,12); SBAR(); \
    const bf16x8 p00=__builtin_bit_cast(bf16x8,PK8(SC0,0)), p10=__builtin_bit_cast(bf16x8,PK8(SC1,0)); SUM4(l0,SC0,0); SUM4(l0,SC0,4); SUM4(l1,SC1,0); SUM4(l1,SC1,4); SBAR(); \
    ot00=MF(VF(v0l,v0h),p00,ot00); \
    const s16x4 v2l=vtr((VP_)+((KS)+1)*1024), v2h=vtr((VP_)+((KS)+1)*1024+512), v3l=vtr((VP_)+4096+((KS)+1)*1024), v3h=vtr((VP_)+4096+((KS)+1)*1024+512); SBAR(); \
    ot10=MF(VF(v0l,v0h),p10,ot10); SUM4(l0,SC0,8); SUM4(l0,SC0,12); SBAR(); \
    ot01=MF(VF(v1l,v1h),p00,ot01); SUM4(l1,SC1,8); SUM4(l1,SC1,12); SBAR(); \
    ot11=MF(VF(v1l,v1h),p10,ot11); const bf16x8 p01=__builtin_bit_cast(bf16x8,PK8(SC0,8)), p11=__builtin_bit_cast(bf16x8,PK8(SC1,8)); SBAR(); \
    ot00=MF(VF(v2l,v2h),p01,ot00); SBAR(); \
    ot10=MF(VF(v2l,v2h),p11,ot10); KLD(kf,KNEXT); SBAR(); \
    ot01=MF(VF(v3l,v3h),p01,ot01); SBAR(); \
    ot11=MF(VF(v3l,v3h),p11,ot11); SBAR(); \
  }while(0)
  bf16x8 kf[4]; f32x16 sA0,sA1,sB0,sB1;
  KLD(kf,kp0);
  sA0=zero16; sA1=zero16;
  #pragma unroll
  for(int d0=0;d0<4;++d0){ sA0=MF(kf[d0],q0f[d0],sA0); sA1=MF(kf[d0],q1f[d0],sA1); }
  SBAR(); KLD(kf,kp0+512); SBAR();
  int sl=0;
  #pragma unroll 1
  for(int t=0;t<NT;++t){
    asm volatile("s_waitcnt vmcnt(0) lgkmcnt(0)\n\ts_barrier":::"memory");
    const int sl1=(sl==2*S2B)?0:sl+S2B;
    if(t+2<NT) DMA64(t+2,((sl>=S2B)?sl-S2B:sl+2*S2B));
    const lds_cptr vp=vp0+sl;
    #define kc (kp0+sl)
    #define kn (kp0+sl1)
    HALFSTEP(sA0,sA1,sB0,sB1,vp,0,kc+SLOTB);
    HALFSTEP(sB0,sB1,sA0,sA1,vp,2,kc+SLOTB+512);
    HALFSTEP(sA0,sA1,sB0,sB1,vp+SLOTB,0,kn);
    HALFSTEP(sB0,sB1,sA0,sA1,vp+SLOTB,2,kn+512);
    #undef kc
    #undef kn
    sl=sl1;
  }
  asm volatile("s_waitcnt vmcnt(0) lgkmcnt(0)\n\ts_barrier":::"memory");
  #undef HALFSTEP
  #undef KLD
  #undef EX4
  #undef PK8
  #undef SUM4
  #undef MF
  #undef VF
  #undef DMA64
  int te_; asm volatile("v_mbcnt_lo_u32_b32 %0, -1, 0\n\tv_mbcnt_hi_u32_b32 %0, -1, %0":"=&v"(te_)); const int r32e=te_&31, hie=te_>>5;
  l0+=__shfl_xor(l0,32); l1+=__shfl_xor(l1,32);
  const float i0=__builtin_amdgcn_rcpf(l0), i1=__builtin_amdgcn_rcpf(l1);
  typedef unsigned u32x2 __attribute__((ext_vector_type(2)));
  #define ST64(OT,INV,ROWOFF,DT,SQ) do{ bf16*op_=O+(rowbase+q0+(ROWOFF)+r32e)*OP+h*D+32*(DT)+4*hie; \
    _Pragma("unroll") for(int rg=0;rg<4;++rg){ u32x2 w_; w_[0]=cvtpk_s(OT[4*rg]*INV,OT[4*rg+1]*INV); w_[1]=cvtpk_s(OT[4*rg+2]*INV,OT[4*rg+3]*INV); *(u32x2*)(op_+8*rg)=w_; \
      const float e0=__uint_as_float(w_[0]<<16),e1=__uint_as_float(w_[0]&0xffff0000u),e2=__uint_as_float(w_[1]<<16),e3=__uint_as_float(w_[1]&0xffff0000u); SQ+=(e0*e0+e1*e1)+(e2*e2+e3*e3); } }while(0)
  float sq0=0.f,sq1=0.f;
  ST64(ot00,i0,0,0,sq0); ST64(ot01,i0,0,1,sq0); ST64(ot10,i1,32,0,sq1); ST64(ot11,i1,32,1,sq1);
  #undef ST64
  sq0+=__shfl_xor(sq0,32); sq1+=__shfl_xor(sq1,32);
  if(hie==0){ fx_atomic_add(ssq+4*(rowbase+q0+r32e),fx_from(sq0,FX_SQ)); fx_atomic_add(ssq+4*(rowbase+q0+32+r32e),fx_from(sq1,FX_SQ)); }
}
constexpr int ATTN_LDS_BYTES=LDS_BYTES;
#undef SBAR
#undef WAIT_BAR
}
namespace mk {
#define LAS __attribute__((address_space(3)))
typedef unsigned short bf16;
typedef unsigned v4u __attribute__((ext_vector_type(4)));
typedef unsigned v2u __attribute__((ext_vector_type(2)));
typedef float f32x4 __attribute__((ext_vector_type(4)));
typedef float f32x16 __attribute__((ext_vector_type(16)));
typedef short bf16x8 __attribute__((ext_vector_type(8)));
typedef short s16x4 __attribute__((ext_vector_type(4)));

constexpr int BATCH = 2, SEQ = 16384, DM = 1024, T = BATCH * SEQ, DEPTH = 2, FF = 4096;
constexpr int NP = 2048;
constexpr int C_AQ = 0, C_AK = 256, C_AV = 384, C_BU = 512, C_BB = 768, C_BC = 1024, C_CU = 1280, C_DQ = 1536, C_DK = 1792, C_DV = 1920;
constexpr float LN_EPS = 1e-5f, RMS_EPS = 1e-6f;
constexpr float DN_ALPHA = 1.41421356237f;
constexpr float LOG2E = 1.4426950408889634f;
constexpr int NWAVES = 8;

constexpr size_t MiB = 1u << 20;
constexpr size_t WS_CS = 16 * 1024, CS_LAYER = 12800  , WS_ZERO_BYTES = 256 * 1024;
constexpr size_t WS_CSF = 512 * 1024  ;
constexpr size_t WS_TAB1 = 1792 * 1024, WS_TAB2 = 1920 * 1024, WS_TAB0 = 1984 * 1024;
constexpr size_t WS_W = 2 * MiB, W_LAYER = 23 * MiB, W_IN = 0, W_OUT = 5 * MiB, W_1 = 7 * MiB, W_2 = 15 * MiB;
constexpr size_t WS_HB = 48 * MiB;
constexpr size_t WS_PROJ = 112 * MiB, WS_QD = 256 * MiB, WS_KD = 272 * MiB, WS_Z = 280 * MiB, WS_MIX = 312 * MiB, WS_ACT = 112 * MiB, WS_SSQ = 376 * MiB  , WS_ST = 378 * MiB, WS_ZERO2_BYTES = 4 * MiB  , WS_END = 381 * MiB;

constexpr int LDS_BYTES = 147456, RING_BYTES = 131072;

struct Args {
    const float* x; const float* ln_in_g; const float* ln_in_b; const float* w_in; const float* conv_w; const float* sink; const float* qn_g; const float* kn_g;
    const float* grp_g; const float* w_out; const float* ln1_g; const float* ln1_b; const float* w1; const float* w2; const float* ln2_g; const float* ln2_b;
    float* out; unsigned char* ws;
};

__device__ __forceinline__ unsigned f2bf(float f) { unsigned u = __builtin_bit_cast(unsigned, f); return (u + 0x7fffu + ((u >> 16) & 1u)) >> 16; }
__device__ __forceinline__ unsigned pk2(float lo, float hi) { return f2bf(lo) | (f2bf(hi) << 16); }
__device__ __forceinline__ unsigned hwpk2(float lo, float hi) { typedef float f2_t __attribute__((ext_vector_type(2))); typedef __bf16 b2_t __attribute__((ext_vector_type(2))); f2_t v = {lo, hi}; b2_t b = __builtin_convertvector(v, b2_t); return __builtin_bit_cast(unsigned, b); }
__device__ __forceinline__ float bf2f(unsigned short b) { return __builtin_bit_cast(float, (unsigned)b << 16); }
__device__ __forceinline__ float bflo(unsigned w) { return __builtin_bit_cast(float, w << 16); }
__device__ __forceinline__ float bfhi(unsigned w) { return __builtin_bit_cast(float, w & 0xffff0000u); }
__device__ __forceinline__ float wave_sum(float v) {
    const int l = mk_lane();
#pragma unroll
    for (int o = 1; o < 64; o <<= 1) v += mk_shfl_xor_l(v, o, l);
    return v;
}
__device__ __forceinline__ float hw_cos(float rev) { return __builtin_amdgcn_cosf(rev); }
__device__ __forceinline__ float hw_sin(float rev) { return __builtin_amdgcn_sinf(rev); }
__device__ __forceinline__ int otid_(int wid_s) { int t; asm volatile("v_mbcnt_lo_u32_b32 %0, -1, 0\n\tv_mbcnt_hi_u32_b32 %0, -1, %0\n\tv_lshl_or_b32 %0, %1, 6, %0" : "=&v"(t) : "s"(wid_s)); return t; }
#define otid() otid_(wid_s)
#define obx() ({ int b_ = bx; asm volatile("" : "+s"(b_)); b_; })
#define ovcu() ({ int v_ = vcu; asm volatile("" : "+s"(v_)); v_; })
__device__ __forceinline__ int crow(int r, int hi) { return (r & 3) + 8 * (r >> 2) + 4 * hi; }

#define XB_TMO      128
#define XB_XCNT(j)  (256  + 64 * (j))
#define XB_XSUB(j)  (1280 + 64 * (j))
#define XB_XGEN(j)  (2304 + 64 * (j))
#define XB_TOP      3328
#define XB_TOPGEN   3392
#define XCD_BAR_WORDS 3456
#define XB_SPIN_CAP (1u << 18)

__device__ __forceinline__ unsigned xb_ld(unsigned* p)              { return __hip_atomic_load(p, __ATOMIC_RELAXED, __HIP_MEMORY_SCOPE_AGENT); }
__device__ __forceinline__ unsigned xb_add(unsigned* p, unsigned v) { return __hip_atomic_fetch_add(p, v, __ATOMIC_RELAXED, __HIP_MEMORY_SCOPE_AGENT); }
__device__ __forceinline__ unsigned xb_xcc_id() { return (unsigned)__builtin_amdgcn_s_getreg((3 << 11) | 20) & 0xFu; }
#define XB_SPIN(cond, bar) do { unsigned _sp = 0; while (cond) { __builtin_amdgcn_s_sleep(1); \
    if ((++_sp & 255u) == 0u) { if (xb_ld(&(bar)[XB_TMO])) break; if (_sp > XB_SPIN_CAP) { atomicAdd(&(bar)[XB_TMO], 1u); break; } } } } while (0)

struct XcdBarrier {
    unsigned* bar; unsigned x;
    volatile LAS unsigned* st;
};

__device__ __forceinline__ XcdBarrier xcd_barrier_post(unsigned* bar, volatile LAS unsigned* st) {
    XcdBarrier b; b.bar = bar; b.x = xb_xcc_id(); b.st = st;
    if (threadIdx.x == 0) (void)xb_add(&bar[XB_XCNT(b.x)], 1u);
    return b;
}
__device__ __forceinline__ void xcd_barrier_complete(unsigned* bar, unsigned x, unsigned& nloc, unsigned& nx) {
    const unsigned G = gridDim.x * gridDim.y * gridDim.z;
    unsigned sum, cnt, mine, sp = 0u;
    for (;;) {
        sum = 0u; cnt = 0u; mine = 0u;
#pragma unroll
        for (unsigned j = 0; j < 16; ++j) { const unsigned c = xb_ld(&bar[XB_XCNT(j)]); sum += c; cnt += (c > 0u) ? 1u : 0u; mine = (j == x) ? c : mine; }
        if (sum == G) break;
        __builtin_amdgcn_s_sleep(1);
        if ((++sp & 255u) == 0u) { if (xb_ld(&bar[XB_TMO])) break; if (sp > XB_SPIN_CAP) { atomicAdd(&bar[XB_TMO], 1u); break; } }
    }
    nloc = mine > 0u ? mine : 1u; nx = cnt > 0u ? cnt : 1u;
}

__device__ __forceinline__ void xcd_barrier(const XcdBarrier& b) {
    asm volatile("s_waitcnt vmcnt(0)" ::: "memory");
    __syncthreads();
    if (threadIdx.x == 0) {
        unsigned* bar = b.bar;
        __builtin_amdgcn_s_waitcnt(0);
        unsigned nloc = b.st[0], nx = b.st[1];
        if (nloc == 0u) { xcd_barrier_complete(bar, b.x, nloc, nx); b.st[0] = nloc; b.st[1] = nx; }
        const unsigned old = xb_add(&bar[XB_XSUB(b.x)], 1u);
        const unsigned gen = old / nloc;
        if (old + 1u == (gen + 1u) * nloc) {
            __builtin_amdgcn_fence(__ATOMIC_RELEASE, "agent");
            asm volatile("s_waitcnt vmcnt(0)" ::: "memory");
            const unsigned og = xb_add(&bar[XB_TOP], 1u);
            const unsigned tg = og / nx;
            if (og + 1u == (tg + 1u) * nx) xb_add(&bar[XB_TOPGEN], 1u);
            else XB_SPIN(xb_ld(&bar[XB_TOPGEN]) == tg, bar);
            __builtin_amdgcn_fence(__ATOMIC_ACQUIRE, "agent");
            xb_add(&bar[XB_XGEN(b.x)], 1u);
            asm volatile("s_waitcnt vmcnt(0)" ::: "memory");
        } else {
            XB_SPIN(xb_ld(&bar[XB_XGEN(b.x)]) == gen, bar);
            __builtin_amdgcn_fence(__ATOMIC_ACQUIRE, "agent");
            asm volatile("s_waitcnt vmcnt(0)" ::: "memory");
        }
    }
    __syncthreads();
}

__device__ __forceinline__ void transpose_item(const float* W, int K, int N, bf16* WT, int k0, int n0, int drow0, LAS float* scr, int lane, const float* gk = nullptr, const float* bk = nullptr, fx_t* cs = nullptr, fx_t* bw = nullptr) {
    { float wv[32];
#pragma unroll
      for (int i = 0; i < 32; ++i) wv[i] = W[(size_t)(k0 + 2 * i + (lane >> 5)) * N + n0 + (lane & 31)];
#pragma unroll
      for (int i = 0; i < 32; ++i) scr[(2 * i + (lane >> 5)) * 33 + (lane & 31)] = wv[i]; }
    asm volatile("s_waitcnt lgkmcnt(0)" ::: "memory");
    const int c = lane & 7;
    float gg[8];
#pragma unroll
    for (int j = 0; j < 8; ++j) gg[j] = gk ? gk[k0 + 8 * c + j] : 1.0f;
#pragma unroll
    for (int j = 0; j < 4; ++j) { const int n = (lane >> 3) + 8 * j; const LAS float* s = scr + (8 * c) * 33 + n;
        v4u o; o.x = hwpk2(s[0 * 33] * gg[0], s[1 * 33] * gg[1]); o.y = hwpk2(s[2 * 33] * gg[2], s[3 * 33] * gg[3]); o.z = hwpk2(s[4 * 33] * gg[4], s[5 * 33] * gg[5]); o.w = hwpk2(s[6 * 33] * gg[6], s[7 * 33] * gg[7]);
        *(v4u*)(WT + (size_t)(drow0 + n) * K + k0 + 8 * c) = o; }
    if (cs) {
        const int n = lane & 31, kh = lane >> 5; float a0 = 0.f, a1 = 0.f;
#pragma unroll
        for (int i = 0; i < 32; ++i) { const int kk = 32 * kh + i; const float w = scr[kk * 33 + n]; a0 += bf2f((unsigned short)f2bf(w * gk[k0 + kk])); a1 += w * bk[k0 + kk]; }
        a0 += __shfl_xor(a0, 32); a1 += __shfl_xor(a1, 32);
        if (lane < 32) { fx_atomic_add(cs + drow0 + n, fx_from(a0, FX_CS)); fx_atomic_add(bw + drow0 + n, fx_from(a1, FX_CS)); }
    }
    asm volatile("s_waitcnt lgkmcnt(0)" ::: "memory");
}
__device__ __forceinline__ void row_to_y(const float* xrow, bf16* yrow, fx_t* st, int lane) {
    const f32x4* xr = (const f32x4*)xrow + lane; v2u* o2 = (v2u*)yrow + lane; float s = 0.f, q = 0.f;
#pragma unroll
    for (int j = 0; j < 4; ++j) { const f32x4 v = xr[64 * j]; v2u w; w.x = hwpk2(v.x, v.y); w.y = hwpk2(v.z, v.w); o2[64 * j] = w;
        const float r0 = bflo(w.x), r1 = bfhi(w.x), r2 = bflo(w.y), r3 = bfhi(w.y); s += (r0 + r1) + (r2 + r3); q += (r0 * r0 + r1 * r1) + (r2 * r2 + r3 * r3); }
    s = wave_sum(s); q = wave_sum(q);
    if (lane == 0) st[0] = st_pack(s, q);
}
__device__ __forceinline__ void y_to_out(const bf16* yrow, const fx_t* st, const float* g, const float* b, float* orow, int lane) {
    float s_, q_; st_unpack(st[0], s_, q_); const float mean = s_ * (1.f / DM), rstd = 1.f / sqrtf(q_ * (1.f / DM) - mean * mean + LN_EPS);
    const v2u* y2 = (const v2u*)yrow + lane; f32x4* o4 = (f32x4*)orow + lane;
#pragma unroll
    for (int j = 0; j < 4; ++j) { const v2u w = y2[64 * j]; const f32x4 gg = ((const f32x4*)g)[lane + 64 * j], bb = ((const f32x4*)b)[lane + 64 * j];
        const f32x4 y = (f32x4){bflo(w.x), bfhi(w.x), bflo(w.y), bfhi(w.y)}; o4[64 * j] = (y - mean) * rstd * gg + bb; }
}
__device__ __forceinline__ void ln_row(const float* xrow, const float* g, const float* b, float* orow, bf16* brow, int lane) {
    const f32x4* xr = (const f32x4*)xrow + lane;
    f32x4 v[4]; float s = 0.f;
#pragma unroll
    for (int j = 0; j < 4; ++j) { v[j] = xr[64 * j]; s += (v[j].x + v[j].y) + (v[j].z + v[j].w); }
    const float mean = wave_sum(s) * (1.f / DM); float s2 = 0.f;
#pragma unroll
    for (int j = 0; j < 4; ++j) { v[j] = v[j] - mean; s2 += (v[j].x * v[j].x + v[j].y * v[j].y) + (v[j].z * v[j].z + v[j].w * v[j].w); }
    const float rstd = 1.f / sqrtf(wave_sum(s2) * (1.f / DM) + LN_EPS);
    f32x4* o4 = (f32x4*)orow + lane; v2u* o2 = (v2u*)brow + lane;
#pragma unroll
    for (int j = 0; j < 4; ++j) { const f32x4 gg = ((const f32x4*)g)[lane + 64 * j], bb = ((const f32x4*)b)[lane + 64 * j];
        const f32x4 y = v[j] * rstd * gg + bb; o4[64 * j] = y; v2u w; w.x = pk2(y.x, y.y); w.y = pk2(y.z, y.w); o2[64 * j] = w; }
}

template <int NB> __device__ __forceinline__ void prep_k_tokens(const bf16* proj, const float* kg, bf16* KD, int t0, int tstride, int lane) {
    const int seg = lane >> 5, j = lane & 15, half = (lane >> 4) & 1;
    const float invf = exp2f(-(float)j * 0.83048202372184f) * 0.15915494309189535f;
    const float gk = kg[lane];
    float x[NB][2];
#pragma unroll
    for (int u = 0; u < NB; ++u) { const int t = t0 + u * tstride; const bf16* pr = proj + (size_t)(t < T ? t : 0) * NP + C_DK + lane; x[u][0] = bf2f(pr[0]); x[u][1] = bf2f(pr[64]); }
#pragma unroll
    for (int u = 0; u < NB; ++u) { const int t = t0 + u * tstride; if (t >= T) break;
        const int tin = t & (SEQ - 1); const float pos = (float)(seg ? (tin & 63) : (tin >> 6));
        const float rev = pos * invf; const float c = hw_cos(rev), s = hw_sin(rev);
#pragma unroll
        for (int hh = 0; hh < 2; ++hh) {
            const float ss = wave_sum(x[u][hh] * x[u][hh]);
            const float xn = x[u][hh] * (1.f / sqrtf(ss * (1.f / 64.f) + RMS_EPS)) * gk;
            const float xp = __shfl_xor(xn, 16);
            const float o = half ? (xn * c + xp * s) : (xn * c - xp * s);
            KD[(size_t)t * 128 + hh * 64 + lane] = (bf16)f2bf(o);
        } }
}
template <int NB> __device__ __forceinline__ void conv_tokens(const bf16* proj, const float* cw  , bf16* mix, fx_t* ssq, int t0, int tstride, int lane) {
    const f32x4 w0 = ((const f32x4*)cw)[lane], w1 = ((const f32x4*)(cw + 256))[lane], w2 = ((const f32x4*)(cw + 512))[lane];
    v2u u0[NB], g0[NB], u1[NB], g1[NB], u2[NB], g2[NB], gb[NB];
#pragma unroll
    for (int u = 0; u < NB; ++u) { const int t = t0 + u * tstride, tc = t < T ? t : 0, tin = tc & (SEQ - 1);
        const bf16* pr = proj + (size_t)tc * NP + 4 * lane;
        u1[u] = *(const v2u*)(pr + C_BU); gb[u] = *(const v2u*)(pr + C_BB); g1[u] = *(const v2u*)(pr + C_BC);
        u0[u] = (v2u){0u, 0u}; g0[u] = u0[u]; u2[u] = u0[u]; g2[u] = u0[u];
        if (tin > 0) { u0[u] = *(const v2u*)(pr - NP + C_BU); g0[u] = *(const v2u*)(pr - NP + C_BC); }
        if (tin < SEQ - 1) { u2[u] = *(const v2u*)(pr + NP + C_BU); g2[u] = *(const v2u*)(pr + NP + C_BC); } }
#pragma unroll
    for (int u = 0; u < NB; ++u) { const int t = t0 + u * tstride; if (t >= T) break;
        float y[4];
        y[0] = bflo(gb[u].x) * (w0.x * (bflo(u0[u].x) * bflo(g0[u].x)) + w1.x * (bflo(u1[u].x) * bflo(g1[u].x)) + w2.x * (bflo(u2[u].x) * bflo(g2[u].x)));
        y[1] = bfhi(gb[u].x) * (w0.y * (bfhi(u0[u].x) * bfhi(g0[u].x)) + w1.y * (bfhi(u1[u].x) * bfhi(g1[u].x)) + w2.y * (bfhi(u2[u].x) * bfhi(g2[u].x)));
        y[2] = bflo(gb[u].y) * (w0.z * (bflo(u0[u].y) * bflo(g0[u].y)) + w1.z * (bflo(u1[u].y) * bflo(g1[u].y)) + w2.z * (bflo(u2[u].y) * bflo(g2[u].y)));
        y[3] = bfhi(gb[u].y) * (w0.w * (bfhi(u0[u].y) * bfhi(g0[u].y)) + w1.w * (bfhi(u1[u].y) * bfhi(g1[u].y)) + w2.w * (bfhi(u2[u].y) * bfhi(g2[u].y)));
        v2u o; o.x = pk2(y[0], y[1]); o.y = pk2(y[2], y[3]);
        *(v2u*)(mix + (size_t)t * DM + 256 + 4 * lane) = o;
        const float r0 = bflo(o.x), r1 = bfhi(o.x), r2 = bflo(o.y), r3 = bfhi(o.y); const float sq = wave_sum((r0 * r0 + r1 * r1) + (r2 * r2 + r3 * r3));
        if (lane == 0) ssq[4 * (size_t)t + 1] = fx_from(sq, FX_SQ); }
}
__device__ __forceinline__ void grpnorm_token(bf16* mix, const float* gg, int t, int lane) {
    v4u* p = (v4u*)(mix + (size_t)t * DM + 16 * lane);
    const v4u a = p[0], b = p[1];
    float v[16];
    v[0] = bflo(a.x); v[1] = bfhi(a.x); v[2] = bflo(a.y); v[3] = bfhi(a.y); v[4] = bflo(a.z); v[5] = bfhi(a.z); v[6] = bflo(a.w); v[7] = bfhi(a.w);
    v[8] = bflo(b.x); v[9] = bfhi(b.x); v[10] = bflo(b.y); v[11] = bfhi(b.y); v[12] = bflo(b.z); v[13] = bfhi(b.z); v[14] = bflo(b.w); v[15] = bfhi(b.w);
    float ss = 0.f;
#pragma unroll
    for (int i = 0; i < 16; ++i) ss += v[i] * v[i];
    ss += __shfl_xor(ss, 1); ss += __shfl_xor(ss, 2); ss += __shfl_xor(ss, 4); ss += __shfl_xor(ss, 8);
    const float rstd = 1.f / sqrtf(ss * (1.f / 256.f) + RMS_EPS);
    const f32x4* g4 = (const f32x4*)(gg + 16 * lane);
#pragma unroll
    for (int q = 0; q < 4; ++q) { const f32x4 g = g4[q]; v[4 * q] *= rstd * g.x; v[4 * q + 1] *= rstd * g.y; v[4 * q + 2] *= rstd * g.z; v[4 * q + 3] *= rstd * g.w; }
    v4u oa, ob;
    oa.x = pk2(v[0], v[1]); oa.y = pk2(v[2], v[3]); oa.z = pk2(v[4], v[5]); oa.w = pk2(v[6], v[7]);
    ob.x = pk2(v[8], v[9]); ob.y = pk2(v[10], v[11]); ob.z = pk2(v[12], v[13]); ob.w = pk2(v[14], v[15]);
    p[0] = oa; p[1] = ob;
}

__device__ __forceinline__ bf16x8 lds_col8(const LAS bf16* p) {
    bf16x8 r;
#pragma unroll
    for (int j = 0; j < 8; ++j) r[j] = (short)p[j * 256];
    return r;
}
__device__ __forceinline__ void f1_unit(const bf16* proj, const bf16* tab0  , const bf16* tab1  , bf16* Z, LAS unsigned char* lds, int b, int t2, int tid, int wid_s) {
    const int lane = tid & 63, wid = tid >> 6, c32 = lane & 31, hi = lane >> 5, n0 = 32 * wid;
    LAS bf16* Xs = (LAS bf16*)lds;
    {
      const int tq = otid(), lq = tq & 63, cq = lq & 31, hq = lq >> 5, hh = wid_s >> 1, ri = wid_s & 1;
      const bf16* ub = proj + ((size_t)b * SEQ + t2) * NP + C_CU + hh * 64 + 8 * hq + (size_t)cq * 128 * NP;
      bf16x8 af[4][4], bfr[2][4];
#pragma unroll
      for (int i = 0; i < 4; ++i)
#pragma unroll
          for (int s = 0; s < 4; ++s) af[i][s] = *(const bf16x8*)(ub + (size_t)(32 * i) * 128 * NP + 16 * s);
#pragma unroll
      for (int j = 0; j < 2; ++j)
#pragma unroll
          for (int s = 0; s < 4; ++s) bfr[j][s] = *(const bf16x8*)(tab0 + (size_t)(ri * 64 + 32 * j + cq) * 64 + 16 * s + 8 * hq);
#pragma unroll
      for (int i = 0; i < 4; ++i)
#pragma unroll
          for (int j = 0; j < 2; ++j) { f32x16 va = f32x16{};
#pragma unroll
              for (int s = 0; s < 4; ++s) va = __builtin_amdgcn_mfma_f32_32x32x16_bf16(af[i][s], bfr[j][s], va, 0, 0, 0);
#pragma unroll
              for (int r = 0; r < 16; r += 2) { const unsigned w2 = hwpk2(va[r], va[r + 1]); LAS bf16* xo = Xs + (ri * 128 + 32 * i + crow(r, hq)) * 256 + hh * 64 + 32 * j + cq; xo[0] = (bf16)(w2 & 0xffffu); xo[256] = (bf16)(w2 >> 16); } } }
    __syncthreads();
    f32x16 acc[8];
#pragma unroll
    for (int i = 0; i < 8; ++i) acc[i] = f32x16{};
    const bf16* ap = tab1 + (size_t)c32 * 256 + 8 * hi;
    bf16x8 an[8];
#pragma unroll
    for (int i = 0; i < 8; ++i) an[i] = *(const bf16x8*)(ap + (size_t)i * 32 * 256);
#pragma unroll 1
    for (int s = 0; s < 16; ++s) {
        bf16x8 ac[8];
#pragma unroll
        for (int i = 0; i < 8; ++i) ac[i] = an[i];
        const int sn = s < 15 ? s + 1 : s;
#pragma unroll
        for (int i = 0; i < 8; ++i) an[i] = *(const bf16x8*)(ap + (size_t)i * 32 * 256 + 16 * sn);
        const bf16x8 bfr = lds_col8(Xs + (16 * s + 8 * hi) * 256 + n0 + c32);
#pragma unroll
        for (int i = 0; i < 8; ++i) acc[i] = __builtin_amdgcn_mfma_f32_32x32x16_bf16(ac[i], bfr, acc[i], 0, 0, 0);
    }
    __syncthreads();
    LAS bf16* Zs = (LAS bf16*)lds;
#pragma unroll
    for (int i = 0; i < 4; ++i)
#pragma unroll
        for (int r = 0; r < 16; ++r) {
            const int k1 = 32 * i + crow(r, hi);
            const float rev = (float)((k1 * t2) & (SEQ - 1)) * (1.0f / SEQ);
            const float ct = hw_cos(rev), st = hw_sin(rev);
            const float zr = acc[i][r], zi = acc[i + 4][r];
            LAS bf16* zo = Zs + k1 * 512 + n0 + c32;
            { const unsigned w2 = hwpk2(zr * ct + zi * st, zi * ct - zr * st); zo[0] = (bf16)(w2 & 0xffffu); zo[256] = (bf16)(w2 >> 16); }
            __builtin_amdgcn_sched_barrier(0);
        }
    __syncthreads();
    { bf16* zb = Z + (((size_t)b * 128) * 128 + t2) * 512; const int tid = otid();
#pragma unroll
      for (int it = 0; it < 16; ++it) { const int c = it * 512 + tid, k1 = c >> 6, c16 = c & 63; *(v4u*)(zb + (size_t)k1 * 128 * 512 + c16 * 8) = *(const LAS v4u*)(Zs + k1 * 512 + c16 * 8); } }
    __syncthreads();
}
__device__ __forceinline__ void f2_unit(const bf16* Z, const bf16* tab2  , bf16* mix, fx_t* ssq, LAS unsigned char* lds, int b, int k1, int tid, int wid_s) {
    const int lane = tid & 63, wid = tid >> 6, c32 = lane & 31, hi = lane >> 5, n0 = 32 * wid;
    LAS bf16* Xs = (LAS bf16*)lds;
    { const bf16* xb = Z + (((size_t)b * 128 + k1) * 128) * 512; const int tid = otid();
      v4u tmp[16];
#pragma unroll
      for (int it = 0; it < 16; ++it) { const int c = it * 512 + tid, row = c >> 5, c16 = c & 31, ri = row >> 7, tt = row & 127; tmp[it] = *(const v4u*)(xb + (size_t)tt * 512 + ri * 256 + c16 * 8); }
#pragma unroll
      for (int it = 0; it < 16; ++it) { const int c = it * 512 + tid; *(LAS v4u*)(Xs + (c >> 5) * 256 + (c & 31) * 8) = tmp[it]; } }
    __syncthreads();
    f32x16 acc[4];
#pragma unroll
    for (int i = 0; i < 4; ++i) acc[i] = f32x16{};
    const bf16* ap = tab2 + (size_t)c32 * 256 + 8 * hi;
    bf16x8 an[4];
#pragma unroll
    for (int i = 0; i < 4; ++i) an[i] = *(const bf16x8*)(ap + (size_t)i * 32 * 256);
#pragma unroll 1
    for (int s = 0; s < 16; ++s) {
        bf16x8 ac[4];
#pragma unroll
        for (int i = 0; i < 4; ++i) ac[i] = an[i];
        const int sn = s < 15 ? s + 1 : s;
#pragma unroll
        for (int i = 0; i < 4; ++i) an[i] = *(const bf16x8*)(ap + (size_t)i * 32 * 256 + 16 * sn);
        const bf16x8 bfr = lds_col8(Xs + (16 * s + 8 * hi) * 256 + n0 + c32);
#pragma unroll
        for (int i = 0; i < 4; ++i) acc[i] = __builtin_amdgcn_mfma_f32_32x32x16_bf16(ac[i], bfr, acc[i], 0, 0, 0);
    }
    __syncthreads();
    LAS bf16* Ys = (LAS bf16*)lds;
#pragma unroll
    for (int i = 0; i < 4; ++i)
#pragma unroll
        for (int r = 0; r < 16; r += 2) { const unsigned w2 = hwpk2(acc[i][r], acc[i][r + 1]); LAS bf16* yo = Ys + (32 * i + crow(r, hi)) * 256 + n0 + c32; yo[0] = (bf16)(w2 & 0xffffu); yo[256] = (bf16)(w2 >> 16); }
    __syncthreads();
    { bf16* yb = mix + ((size_t)b * SEQ + k1) * DM + 512; const int tid = otid();
#pragma unroll
      for (int it = 0; it < 8; ++it) { const int c = it * 512 + tid, k2 = c >> 5, c16 = c & 31; const v4u v = *(const LAS v4u*)(Ys + k2 * 256 + c16 * 8); *(v4u*)(yb + (size_t)k2 * 128 * DM + c16 * 8) = v;
          float sq = (bflo(v.x) * bflo(v.x) + bfhi(v.x) * bfhi(v.x)) + (bflo(v.y) * bflo(v.y) + bfhi(v.y) * bfhi(v.y)) + (bflo(v.z) * bflo(v.z) + bfhi(v.z) * bfhi(v.z)) + (bflo(v.w) * bflo(v.w) + bfhi(v.w) * bfhi(v.w));
          sq += __shfl_xor(sq, 1); sq += __shfl_xor(sq, 2); sq += __shfl_xor(sq, 4); sq += __shfl_xor(sq, 8); sq += __shfl_xor(sq, 16);
          if (c16 == 0) ssq[4 * ((size_t)b * SEQ + k1 + 128 * k2) + 2] = fx_from(sq, FX_SQ); } }
    __syncthreads();
}

constexpr int WA_KROW = 72, WA_VROW = 392, WA_LDS_V = 384 * WA_KROW * 2;
__device__ __forceinline__ void wina_unit(const bf16* proj, const float* sink, bf16* mix, fx_t* ssq, LAS unsigned char* lds, int b, int qt, int kvh, int tid) {
    const int lane = tid & 63, wid = tid >> 6, c32 = lane & 31, hi = lane >> 5;
    const int q0 = qt * 128, kbase = q0 - 128;
    const int kbeg = kbase < 0 ? 0 : kbase, kend = (q0 + 256 > SEQ) ? SEQ : q0 + 256, nkv = kend - kbeg;
    LAS bf16* Ks = (LAS bf16*)lds; LAS bf16* Vt = (LAS bf16*)(lds + WA_LDS_V);
    const bf16* pb = proj + (size_t)b * SEQ * NP;
    { v4u kk[6], vv[6];
#pragma unroll
      for (int it = 0; it < 6; ++it) { const int idx = it * (NWAVES * 64) + tid; const int ic = idx < nkv * 8 ? idx : 0, ch = ic / nkv, row = ic - ch * nkv, kv = kbeg + row;
          kk[it] = *(const v4u*)(pb + (size_t)kv * NP + C_AK + kvh * 64 + ch * 8); vv[it] = *(const v4u*)(pb + (size_t)kv * NP + C_AV + kvh * 64 + ch * 8); }
#pragma unroll
      for (int it = 0; it < 6; ++it) { const int idx = it * (NWAVES * 64) + tid; if (idx < nkv * 8) {
          const int ch = idx / nkv, row = idx - ch * nkv, lr = kbeg + row - kbase;
          *(LAS v4u*)(Ks + lr * WA_KROW + ch * 8) = kk[it];
          LAS bf16* vp = Vt + (ch * 8) * WA_VROW + lr; const v4u v = vv[it];
          vp[0] = (bf16)(v.x & 0xffffu); vp[WA_VROW] = (bf16)(v.x >> 16); vp[2 * WA_VROW] = (bf16)(v.y & 0xffffu); vp[3 * WA_VROW] = (bf16)(v.y >> 16);
          vp[4 * WA_VROW] = (bf16)(v.z & 0xffffu); vp[5 * WA_VROW] = (bf16)(v.z >> 16); vp[6 * WA_VROW] = (bf16)(v.w & 0xffffu); vp[7 * WA_VROW] = (bf16)(v.w >> 16); } } }
    __syncthreads();
    const int g = wid >> 2, h = kvh * 2 + g, qw = q0 + 32 * (wid & 3), qpos = qw + c32;
    bf16x8 qf[4];
    { const bf16* qp = pb + (size_t)qpos * NP + C_AQ + h * 64 + 8 * hi;
#pragma unroll
      for (int d0 = 0; d0 < 4; ++d0) qf[d0] = *(const bf16x8*)(qp + 16 * d0); }
    const float slope2 = __builtin_amdgcn_exp2f(-2.0f * (float)(h + 1)) * LOG2E, sc2 = 0.125f * LOG2E, sink2 = sink[h] * LOG2E;
    float m = sink2, l = 0.f;
    f32x16 ot[2]; ot[0] = f32x16{}; ot[1] = f32x16{};
    const int t_lo = (qw - 128 < 0) ? 0 : qw - 128, t_hi = (qw + 160 > SEQ) ? SEQ : qw + 160;
    for (int kv0 = t_lo; kv0 < t_hi; kv0 += 32) {
        const int lr = kv0 - kbase;
        f32x16 sacc = f32x16{};
#pragma unroll
        for (int d0 = 0; d0 < 4; ++d0) { const bf16x8 kf = *(const LAS bf16x8*)(Ks + (lr + c32) * WA_KROW + 16 * d0 + 8 * hi); sacc = __builtin_amdgcn_mfma_f32_32x32x16_bf16(kf, qf[d0], sacc, 0, 0, 0); }
        float x[16]; float mx = -1e30f;
#pragma unroll
        for (int r = 0; r < 16; ++r) { const int kv = kv0 + crow(r, hi); int dist = qpos - kv; dist = dist < 0 ? -dist : dist;
            x[r] = (dist <= 128) ? (sacc[r] * sc2 - slope2 * (float)dist) : -1e30f; mx = fmaxf(mx, x[r]); }
        mx = fmaxf(mx, __shfl_xor(mx, 32));
        const float mnew = fmaxf(m, mx), alpha = __builtin_amdgcn_exp2f(m - mnew); const bool grow = __any(mnew > m); m = mnew;
        float ps = 0.f;
#pragma unroll
        for (int r = 0; r < 16; ++r) { x[r] = __builtin_amdgcn_exp2f(x[r] - m); ps += x[r]; }
        l = l * alpha + ps;
        if (grow) {
#pragma unroll
            for (int r = 0; r < 16; ++r) { ot[0][r] *= alpha; ot[1][r] *= alpha; } }
        v4u pw0, pw1;
        pw0.x = hwpk2(x[0], x[1]); pw0.y = hwpk2(x[2], x[3]); pw0.z = hwpk2(x[4], x[5]); pw0.w = hwpk2(x[6], x[7]);
        pw1.x = hwpk2(x[8], x[9]); pw1.y = hwpk2(x[10], x[11]); pw1.z = hwpk2(x[12], x[13]); pw1.w = hwpk2(x[14], x[15]);
        const bf16x8 pa0 = __builtin_bit_cast(bf16x8, pw0), pa1 = __builtin_bit_cast(bf16x8, pw1);
#pragma unroll
        for (int dt = 0; dt < 2; ++dt) {
            const LAS bf16* vb = Vt + (32 * dt + c32) * WA_VROW + lr + 4 * hi;
            const s16x4 a0 = *(const LAS s16x4*)(vb), a1 = *(const LAS s16x4*)(vb + 8), b0 = *(const LAS s16x4*)(vb + 16), b1 = *(const LAS s16x4*)(vb + 24);
            const bf16x8 v0 = (bf16x8){a0[0], a0[1], a0[2], a0[3], a1[0], a1[1], a1[2], a1[3]}, v1 = (bf16x8){b0[0], b0[1], b0[2], b0[3], b1[0], b1[1], b1[2], b1[3]};
            ot[dt] = __builtin_amdgcn_mfma_f32_32x32x16_bf16(v0, pa0, ot[dt], 0, 0, 0);
            ot[dt] = __builtin_amdgcn_mfma_f32_32x32x16_bf16(v1, pa1, ot[dt], 0, 0, 0);
        }
    }
    l += __shfl_xor(l, 32); l += __builtin_amdgcn_exp2f(sink2 - m);
    const float inv = 1.0f / l;
    bf16* op = mix + ((size_t)b * SEQ + qpos) * DM + h * 64 + 4 * hi; float sq = 0.f;
#pragma unroll
    for (int dt = 0; dt < 2; ++dt)
#pragma unroll
        for (int rg = 0; rg < 4; ++rg) { v2u o; o.x = hwpk2(ot[dt][4 * rg] * inv, ot[dt][4 * rg + 1] * inv); o.y = hwpk2(ot[dt][4 * rg + 2] * inv, ot[dt][4 * rg + 3] * inv);
            *(v2u*)(op + 32 * dt + 8 * rg) = o; sq += (bflo(o.x) * bflo(o.x) + bfhi(o.x) * bfhi(o.x)) + (bflo(o.y) * bflo(o.y) + bfhi(o.y) * bfhi(o.y)); }
    sq += __shfl_xor(sq, 32);
    if (hi == 0) fx_atomic_add(ssq + 4 * ((size_t)b * SEQ + qpos), fx_from(sq, FX_SQ));
    __syncthreads();
}

typedef const __attribute__((address_space(4))) Args* kargs_t;
__device__ __forceinline__ kargs_t kargs() { kargs_t p = (kargs_t)__builtin_amdgcn_kernarg_segment_ptr(); asm volatile("" : "+s"(p)); return p; }
#define KA (kargs())
#define WSB ((unsigned char*)KA->ws)
#define TAB1 ((bf16*)(WSB + WS_TAB1))
#define TAB2 ((bf16*)(WSB + WS_TAB2))
#define TAB0 ((bf16*)(WSB + WS_TAB0))
#define HB ((bf16*)(WSB + WS_HB))
#define PROJ ((bf16*)(WSB + WS_PROJ))
#define KD ((bf16*)(WSB + WS_KD))
#define ZB ((bf16*)(WSB + WS_Z))
#define MIX ((bf16*)(WSB + WS_MIX))
#define ACT ((bf16*)(WSB + WS_ACT))
#define CS ((fx_t*)(WSB + WS_CS))
#define CSF ((float*)(WSB + WS_CSF))
#define ST ((fx_t*)(WSB + WS_ST))
__global__ void __launch_bounds__(NWAVES * 64, 2) hymba_fwd(Args a) {
    extern __shared__ __attribute__((aligned(16))) unsigned char lds_raw[];
    cg::grid_group grid = cg::this_grid();
    LAS unsigned char* lds = (LAS unsigned char*)lds_raw;
    const int wid_s = __builtin_amdgcn_readfirstlane((int)threadIdx.x >> 6);
    const int tid = otid(), lane = tid & 63, wid = wid_s;
    const int G = gridDim.x, bx = blockIdx.x;
    const int vcu = (G % 8 == 0) ? (bx % 8) * (G / 8) + bx / 8 : bx;
    const int gw = vcu * NWAVES + wid, NGW = G * NWAVES;
    volatile LAS unsigned* MISC = (volatile LAS unsigned*)(lds + RING_BYTES + 320);
    if (tid < 32) MISC[tid] = 0u;
    __syncthreads();
    (void)xcd_barrier_post((unsigned*)WSB, MISC + 8);
#define GSYNC() do { XcdBarrier b_; b_.bar = (unsigned*)WSB; b_.x = xb_xcc_id(); b_.st = (volatile LAS unsigned*)(lds + RING_BYTES + 320) + 8; xcd_barrier(b_); } while (0)
    if (KA->ws == nullptr) grid.sync();

    {
        LAS float* scr = (LAS float*)(lds + wid * 16384);
        constexpr int I_IN = 16 * 64, I_FO = 0, I_OUT = 16 * 32, I_1 = 16 * 128, I_2 = 64 * 32, I_L = I_IN + I_FO + I_OUT + I_1 + I_2;
        for (int it = gw; it < DEPTH * I_L; it += NGW) {
            const int L = it / I_L; int r = it % I_L;
            unsigned char* wl = WSB + WS_W + (size_t)L * W_LAYER; fx_t* csl = CS + (size_t)L * CS_LAYER;
            const float* gin = L ? KA->ln2_g + (L - 1) * DM : KA->ln_in_g; const float* bin = L ? KA->ln2_b + (L - 1) * DM : KA->ln_in_b;
            if (r < I_IN) { const int kb = r / 64, nb = r % 64, n0 = 32 * nb;
                transpose_item(KA->w_in + (size_t)L * 1024 * 2048, 1024, 2048, (bf16*)(wl + W_IN), 64 * kb, n0, n0, scr, lane, gin, bin, csl, csl + 2304); continue; } r -= I_IN;
            r -= 0;
            if (r < I_OUT) { transpose_item(KA->w_out + (size_t)L * 1024 * 1024, 1024, 1024, (bf16*)(wl + W_OUT), 64 * (r / 32), 32 * (r % 32), 32 * (r % 32), scr, lane, KA->grp_g + L * DM); continue; } r -= I_OUT;
            if (r < I_1) { transpose_item(KA->w1 + (size_t)L * 1024 * 4096, 1024, 4096, (bf16*)(wl + W_1), 64 * (r / 128), 32 * (r % 128), 32 * (r % 128), scr, lane, KA->ln1_g + L * DM, KA->ln1_b + L * DM, csl + 4608, csl + 4608 + 4096); continue; } r -= I_1;
            transpose_item(KA->w2 + (size_t)L * 4096 * 1024, 4096, 1024, (bf16*)(wl + W_2), 64 * (r / 32), 32 * (r % 32), 32 * (r % 32), scr, lane);
        }
        const int gt = vcu * NWAVES * 64 + tid, NGT = G * NWAVES * 64;
        const float rs = 0.08838834764831845f;
        for (int e = gt; e < 256 * 256; e += NGT) { const int m = e >> 8, k = e & 255, ro = m >> 7, k1 = m & 127, ri = k >> 7, t1 = k & 127;
            const float rev = (float)((k1 * t1) & 127) * (1.0f / 128.0f); const float c = hw_cos(rev) * rs, s = hw_sin(rev) * rs;
            TAB1[e] = (bf16)f2bf(ro == ri ? c : (ro == 0 ? s : -s)); }
        for (int e = gt; e < 128 * 256; e += NGT) { const int k2 = e >> 8, k = e & 255, ri = k >> 7, tt = k & 127;
            const float rev = (float)((k2 * tt) & 127) * (1.0f / 128.0f);
            TAB2[e] = (bf16)f2bf((ri == 0 ? hw_cos(rev) : hw_sin(rev)) * rs); }
        for (int e = gt; e < 128 * 64; e += NGT) { const int n = e >> 6, c = e & 63, ri = n >> 6, cp = n & 63;
            const float rev = (float)((c * cp) & 63) * (1.0f / 64.0f);
            TAB0[e] = (bf16)f2bf((ri == 0 ? hw_cos(rev) : -hw_sin(rev)) * 0.125f); }
#pragma unroll 4
        for (int m = gw; m < T; m += NGW) row_to_y(KA->x + (size_t)m * DM, HB + (size_t)m * DM, ST + (size_t)m, lane);
    }
    GSYNC();

    for (int L = 0; L < DEPTH; ++L) {
#define wl (WSB + WS_W + (size_t)L * W_LAYER)
#define csl (CS + (size_t)L * CS_LAYER)
#define csf (CSF + (size_t)L * CS_LAYER)
#define gin (L ? KA->ln2_g + (L - 1) * DM : KA->ln_in_g)
#define bin (L ? KA->ln2_b + (L - 1) * DM : KA->ln_in_b)
#define SSQ ((fx_t*)(WSB + WS_SSQ) + (size_t)L * (4 * T))
#define st0 (ST + (size_t)(2 * L) * T)
#define st1 (ST + (size_t)(2 * L + 1) * T)
#define st2 (ST + (size_t)(2 * L + 2) * T)
        { pg8::Gemm g{HB, (const bf16*)(wl + W_IN), T, NP, DM}; pg8::StaticOrder S; S.init(T, NP, G, obx());
          if (L == 0) { pg8::EpiLnBf16<0, true> E{PROJ, NP, st0, csl, csl + 2304, LN_EPS, lds + RING_BYTES + 1024};
              pg8::gemm_phase<pg8::EpiLnBf16<0, true>, pg8::StaticOrder, true, true>(lds, g, S, E, otid()); }
          else { pg8::EpiLnBf16<0> E{PROJ, NP, st0, csf, csf + 2304, LN_EPS, lds + RING_BYTES + 1024};
              pg8::gemm_phase<pg8::EpiLnBf16<0>, pg8::StaticOrder, true, true>(lds, g, S, E, otid()); } }
        GSYNC();
        if (L == 0) { const int pt = otid(); for (int e = vcu * NWAVES * 64 + pt; e < DEPTH * (int)CS_LAYER; e += G * NWAVES * 64) CSF[e] = fx_to(CS[e], FX_CS); }
        { const int pt = otid(), pl = pt & 63, pw = vcu * NWAVES + (pt >> 6); for (int t = pw; t < T; t += 8 * NGW) prep_k_tokens<8>(PROJ, KA->kn_g + L * 64, KD, t, NGW, pl); }
        { const int pt = otid(), pl = pt & 63, pw = vcu * NWAVES + (pt >> 6); for (int t = pw; t < T; t += 8 * NGW) conv_tokens<8>(PROJ, KA->conv_w + L * 768, MIX, SSQ, t, NGW, pl); }
        { const int pt = otid(); for (int u = ovcu(); u < BATCH * 128; u += G) f1_unit(PROJ, TAB0, TAB1, ZB, lds, u >> 7, u & 127, pt, wid_s); }
        { const int pt = otid(); for (int u = ovcu(); u < BATCH * 128 * 2; u += G) wina_unit(PROJ, KA->sink + L * 4, MIX, SSQ, lds, u >> 8, (u >> 1) & 127, u & 1, pt); }
        GSYNC();
        {
          for (int uid = ovcu(); uid < 256; uid += G) { const int bk = uid >> 6, r = uid & 63, b = bk >> 1, h = (bk & 1) * 2 + (r >> 5), qb = r & 31;
              attn_body::attn_unit64(b, h, qb, (const attn_body::bf16*)(PROJ + C_DQ), (const attn_body::bf16*)KD, (const attn_body::bf16*)(PROJ + C_DV), (attn_body::bf16*)(MIX + 768), (char*)lds_raw, KA->qn_g + L * 64, KA->kn_g + L * 64, SSQ + 3, wid_s); } }
        { const int pt = otid(); for (int u = ovcu(); u < BATCH * 128; u += G) f2_unit(ZB, TAB2, MIX, SSQ, lds, u >> 7, u & 127, pt, wid_s); }
        GSYNC();
        { pg8::Gemm g{MIX, (const bf16*)(wl + W_OUT), T, DM, DM}; pg8::StaticOrder S; S.init(T, DM, G, obx());
          pg8::EpiResLn E{HB, DM, st0, st1, gin, bin, DN_ALPHA, LN_EPS}; pg8::GroupScale R{SSQ, RMS_EPS, (LAS float*)(lds + RING_BYTES + 1024)};
          { const int pt = otid(); pg8::Unit u0; for (int i = 0; i < 2; ++i) if (S.next(i, u0)) R.prepare(u0, i, pt); }
          __syncthreads();
          pg8::gemm_phase<pg8::EpiResLn, pg8::StaticOrder, true, true, pg8::GroupScale>(lds, g, S, E, otid(), R); }
        GSYNC();
        { pg8::Gemm g{HB, (const bf16*)(wl + W_1), T, FF, DM}; pg8::StaticOrder S; S.init(T, FF, G, obx());
          pg8::EpiLnBf16<2> E{ACT, FF, st1, csf + 4608, csf + 4608 + 4096, LN_EPS, lds + RING_BYTES + 1024};
          pg8::gemm_phase<pg8::EpiLnBf16<2>, pg8::StaticOrder, true, true>(lds, g, S, E, otid()); }
        GSYNC();
        { pg8::Gemm g{ACT, (const bf16*)(wl + W_2), T, DM, FF}; pg8::StaticOrder S; S.init(T, DM, G, obx());
          pg8::EpiResLn E{HB, DM, st1, st2, KA->ln1_g + L * DM, KA->ln1_b + L * DM, DN_ALPHA, LN_EPS};
          pg8::gemm_phase<pg8::EpiResLn, pg8::StaticOrder, true, true>(lds, g, S, E, otid()); }
        GSYNC();
    }
    { const int pt = otid(), pl = pt & 63, pw = vcu * NWAVES + (pt >> 6); const fx_t* stf = ST + (size_t)(2 * DEPTH) * T;
#pragma unroll 4
      for (int m = pw; m < T; m += NGW) y_to_out(HB + (size_t)m * DM, stf + (size_t)m, KA->ln2_g + (DEPTH - 1) * DM, KA->ln2_b + (DEPTH - 1) * DM, KA->out + (size_t)m * DM, pl); }
}
#undef wl
#undef csl
#undef gin
#undef bin
#undef SSQ
#undef st0
#undef st1
#undef st2
}

extern "C" void kernel_launch(void* const* d_in, const int* in_sizes, int n_in, void* d_out, int out_size, void* d_ws, size_t ws_size, hipStream_t stream) {
    static int grid = 0;
    if (grid == 0) {
        if (n_in != 16 || out_size != mk::T * mk::DM || ws_size < mk::WS_END) { fprintf(stderr, "kernel_launch: unexpected shapes (n_in %d, out %d, ws %zu)\n", n_in, out_size, ws_size); grid = -1; return; }
        int dev = 0, cus = 0, per_cu = 0;
        (void)hipGetDevice(&dev); (void)hipDeviceGetAttribute(&cus, hipDeviceAttributeMultiprocessorCount, dev);
        if (hipFuncSetAttribute((const void*)mk::hymba_fwd, hipFuncAttributeMaxDynamicSharedMemorySize, mk::LDS_BYTES) != hipSuccess) { fprintf(stderr, "kernel_launch: hipFuncSetAttribute failed\n"); grid = -1; return; }
        if (hipOccupancyMaxActiveBlocksPerMultiprocessor(&per_cu, (const void*)mk::hymba_fwd, mk::NWAVES * 64, mk::LDS_BYTES) != hipSuccess || per_cu < 1) { fprintf(stderr, "kernel_launch: occupancy query says %d\n", per_cu); per_cu = 1; }
        (void)hipGetLastError();
        grid = cus * 1;
        if (grid * 2 < 512) { fprintf(stderr, "kernel_launch: this build needs >= 256 workgroups (got %d)\n", grid); grid = -1; return; }
    }
    if (grid < 0) return;
    if (hipMemsetAsync(d_ws, 0, mk::WS_ZERO_BYTES, stream) != hipSuccess) { fprintf(stderr, "kernel_launch: memset of the barrier words failed\n"); return; }
    if (hipMemsetAsync((char*)d_ws + mk::WS_SSQ, 0, mk::WS_ZERO2_BYTES, stream) != hipSuccess) { fprintf(stderr, "kernel_launch: memset of the group sums failed\n"); return; }
    mk::Args a{};
    const float** pp = (const float**)&a;
    for (int i = 0; i < 16; ++i) pp[i] = (const float*)d_in[i];
    a.out = (float*)d_out; a.ws = (unsigned char*)d_ws;
    void* args[] = {&a};
    hipError_t e = hipLaunchCooperativeKernel((const void*)mk::hymba_fwd, dim3(grid), dim3(mk::NWAVES * 64), args, mk::LDS_BYTES, stream);
    if (e != hipSuccess) fprintf(stderr, "cooperative launch failed: %s (grid %d)\n", hipGetErrorString(e), grid);
}
```
